# Optimizing an MI355X kernel written in HIP

```python
import math
import jax, jax.numpy as jnp
from jax import lax
import numpy as np

D_MODEL = 1024
BATCH = 4
SEQ = 8192
DEPTH = 2

CHUNK = 64
HEAD_DIM = 64
N_HEADS_A = 8
N_HEADS_B = 8
WIDTH_A = N_HEADS_A * HEAD_DIM
WIDTH_B = N_HEADS_B * HEAD_DIM
LEFT_CHUNKS = 8
BAND = (LEFT_CHUNKS + 1) * CHUNK
REL_CLIP = 256
N_REL = 2 * REL_CLIP + 1
SB_BLOCK = 128
D_FF = -(-8 * D_MODEL // (3 * 256)) * 256
IN_COLS = 3 * WIDTH_A + 3 * WIDTH_B + 2 * D_MODEL
DEEPNORM_ALPHA = (2 * DEPTH) ** 0.25
DEEPNORM_BETA = (8 * DEPTH) ** -0.25
LN_EPS = 1e-5

kernel_name = "hybrid_chunk_relbias_stickbreaking_deepnorm"


def layer_norm(x, g, b):
    xf = x.astype(jnp.float32)
    mu = jnp.mean(xf, axis=-1, keepdims=True)
    var = jnp.mean(jnp.square(xf - mu), axis=-1, keepdims=True)
    y = (xf - mu) * lax.rsqrt(var + LN_EPS) * g.astype(jnp.float32) + b.astype(jnp.float32)
    return y.astype(x.dtype)


def chunk_band_attention(q, k, v, rel_bias):
    B, S, H, dh = q.shape
    nc = S // CHUNK
    qc = q.reshape(B, nc, CHUNK, H, dh)
    pad = ((0, 0), (LEFT_CHUNKS * CHUNK, 0), (0, 0), (0, 0))
    kp = jnp.pad(k, pad).reshape(B, nc + LEFT_CHUNKS, CHUNK, H, dh)
    vp = jnp.pad(v, pad).reshape(B, nc + LEFT_CHUNKS, CHUNK, H, dh)
    kb = jnp.concatenate([kp[:, j:j + nc] for j in range(LEFT_CHUNKS + 1)], axis=2)
    vb = jnp.concatenate([vp[:, j:j + nc] for j in range(LEFT_CHUNKS + 1)], axis=2)
    scores = jnp.einsum('bcqhd,bckhd->bhcqk', qc, kb).astype(jnp.float32) / math.sqrt(dh)
    i = jnp.arange(CHUNK)[:, None]
    p = jnp.arange(BAND)[None, :]
    dist = LEFT_CHUNKS * CHUNK + i - p
    idx = jnp.clip(dist, -REL_CLIP, REL_CLIP) + REL_CLIP
    bias = rel_bias.astype(jnp.float32)[:, idx]
    valid = (jnp.arange(nc)[:, None] + jnp.arange(BAND)[None, :] // CHUNK - LEFT_CHUNKS) >= 0
    scores = scores + bias[None, :, None, :, :]
    scores = jnp.where(valid[None, None, :, None, :], scores, -jnp.inf)
    probs = jax.nn.softmax(scores, axis=-1).astype(v.dtype)
    out = jnp.einsum('bhcqk,bckhd->bcqhd', probs, vb)
    return out.reshape(B, S, H * dh)


def stick_breaking_attention(q, k, v):
    B, S, H, dh = q.shape
    nb = S // SB_BLOCK
    scale = 1.0 / math.sqrt(dh)
    qb = q.reshape(B, nb, SB_BLOCK, H, dh).transpose(1, 0, 2, 3, 4)
    key_pos = jnp.arange(S)

    def one_block(args):
        q_blk, blk = args
        z = jnp.einsum('bqhd,bshd->bhqs', q_blk, k).astype(jnp.float32) * scale
        t = blk * SB_BLOCK + jnp.arange(SB_BLOCK)
        causal = (key_pos[None, :] < t[:, None])[None, None]
        log_keep = jnp.where(causal, jax.nn.log_sigmoid(-z), 0.0)
        suffix = lax.cumsum(log_keep, axis=3, reverse=True) - log_keep
        log_w = jnp.where(causal, jax.nn.log_sigmoid(z) + suffix, -jnp.inf)
        w = jnp.exp(log_w).astype(v.dtype)
        return jnp.einsum('bhqs,bshd->bqhd', w, v)

    out = lax.map(one_block, (qb, jnp.arange(nb)))
    return out.transpose(1, 0, 2, 3, 4).reshape(B, S, H * dh)


def setup_inputs(seed: int = 0) -> dict:
    key = jax.random.key(seed)
    ks = jax.random.split(key, 16)
    D = D_MODEL
    x = jax.random.normal(ks[0], (BATCH, SEQ, D), jnp.float32)
    w_in = jax.random.normal(ks[1], (DEPTH, D, IN_COLS), jnp.float32) * D ** -0.5
    col_scale = jnp.concatenate([
        jnp.ones((2 * WIDTH_A,)), jnp.full((WIDTH_A,), DEEPNORM_BETA),
        jnp.ones((2 * WIDTH_B,)), jnp.full((WIDTH_B,), DEEPNORM_BETA),
        jnp.ones((2 * D,))]).astype(jnp.float32)
    w_in = w_in * col_scale
    b_gate = 0.01 * jax.random.normal(ks[2], (DEPTH, 2 * D), jnp.float32)
    rel_bias = 0.1 * jax.random.normal(ks[3], (DEPTH, N_HEADS_A, N_REL), jnp.float32)
    w_proj_a = jax.random.normal(ks[4], (DEPTH, WIDTH_A, D), jnp.float32) * WIDTH_A ** -0.5
    w_proj_b = jax.random.normal(ks[5], (DEPTH, WIDTH_B, D), jnp.float32) * WIDTH_B ** -0.5
    w_out = jax.random.normal(ks[6], (DEPTH, D, D), jnp.float32) * (D ** -0.5 * DEEPNORM_BETA)
    ln1_g = 1.0 + 0.02 * jax.random.normal(ks[7], (DEPTH, D), jnp.float32)
    ln1_b = 0.02 * jax.random.normal(ks[8], (DEPTH, D), jnp.float32)
    w_ffn_in = jax.random.normal(ks[9], (DEPTH, D, 2 * D_FF), jnp.float32) * D ** -0.5
    w_ffn_out = jax.random.normal(ks[10], (DEPTH, D_FF, D), jnp.float32) * (D_FF ** -0.5 * DEEPNORM_BETA)
    ln2_g = 1.0 + 0.02 * jax.random.normal(ks[11], (DEPTH, D), jnp.float32)
    ln2_b = 0.02 * jax.random.normal(ks[12], (DEPTH, D), jnp.float32)
    return {"x": x, "w_in": w_in, "b_gate": b_gate, "rel_bias": rel_bias,
            "w_proj_a": w_proj_a, "w_proj_b": w_proj_b, "w_out": w_out,
            "ln1_g": ln1_g, "ln1_b": ln1_b, "w_ffn_in": w_ffn_in,
            "w_ffn_out": w_ffn_out, "ln2_g": ln2_g, "ln2_b": ln2_b}


def reference(x, w_in, b_gate, rel_bias, w_proj_a, w_proj_b, w_out,
              ln1_g, ln1_b, w_ffn_in, w_ffn_out, ln2_g, ln2_b):
    B, S, D = x.shape
    split_pts = np.cumsum([WIDTH_A, WIDTH_A, WIDTH_A, WIDTH_B, WIDTH_B, WIDTH_B, D]).tolist()
    for l in range(DEPTH):
        h = x @ w_in[l]
        qa, ka, va, qb, kb, vb, ga, gb = jnp.split(h, split_pts, axis=-1)
        heads_a = lambda t: t.reshape(B, S, N_HEADS_A, HEAD_DIM)
        heads_b = lambda t: t.reshape(B, S, N_HEADS_B, HEAD_DIM)
        y_a = chunk_band_attention(heads_a(qa), heads_a(ka), heads_a(va), rel_bias[l]) @ w_proj_a[l]
        y_b = stick_breaking_attention(heads_b(qb), heads_b(kb), heads_b(vb)) @ w_proj_b[l]
        gate_a = jax.nn.sigmoid(ga + b_gate[l, :D])
        gate_b = jax.nn.sigmoid(gb + b_gate[l, D:])
        mix = (gate_a * y_a + gate_b * y_b) @ w_out[l]
        x = layer_norm(DEEPNORM_ALPHA * x + mix, ln1_g[l], ln1_b[l])
        gu = x @ w_ffn_in[l]
        g, u = jnp.split(gu, 2, axis=-1)
        ffn = (jax.nn.silu(g) * u) @ w_ffn_out[l]
        x = layer_norm(DEEPNORM_ALPHA * x + ffn, ln2_g[l], ln2_b[l])
    return x
```

```cpp
#include <hip/hip_runtime.h>
#include <cstdio>
#include <cstdint>
namespace pg8 {
#define PG8_LAS __attribute__((address_space(3)))
typedef unsigned short bf16_t;
typedef short bf16x8 __attribute__((ext_vector_type(8)));
typedef float f32x4 __attribute__((ext_vector_type(4)));
typedef unsigned u32x4 __attribute__((ext_vector_type(4)));
constexpr int BM = 256, BK = 64, HALF = 128, HTB = HALF * BK * 2  , STAGE_BYTES = 8 * HTB, NXCD = 8, WGM = 8;

__host__ __device__ __forceinline__ int lds_byte(int r, int c) { const int st = (r >> 4) * 2 + (c >> 5), rr = r & 15, cc = c & 31, ob = rr * 64 + cc * 2; return st * 1024 + (ob ^ (((ob >> 9) & 1) << 5)); }
__host__ __device__ __forceinline__ void stage_rc(int b, int& R, int& C) { const int st = b / 1024, sb = b % 1024, swz = sb ^ (((sb >> 9) & 1) << 5); R = (st >> 1) * 16 + swz / 64; C = (st & 1) * 32 + (swz % 64) / 2; }
__host__ __device__ __forceinline__ int perm32(int rho) { const int n = rho >> 4, i = rho & 15; return 8 * (i >> 2) + 4 * n + (i & 3); }

struct Unit { int pm, pn; };
struct Gemm { const bf16_t* A; const bf16_t* Bt; int M, N, K; };

struct StaticOrder {
    int nM, nN, nwg, G, c;
    __host__ __device__ void init(int M, int N, int G_, int c_) { nM = M / BM; nN = N / BM; nwg = nM * nN; G = G_; c = c_; }
    __host__ __device__ bool next(int i, Unit& u) const {
        const long L = (long)i * G + c; if (L >= nwg) return false;
        int wgid = (int)L; { const int q = nwg / NXCD, r = nwg % NXCD, xcd = wgid % NXCD, off = wgid / NXCD; wgid = (xcd < r ? xcd * (q + 1) : r * (q + 1) + (xcd - r) * q) + off; }
        const int nig = WGM * nN, gid = wgid / nig, fm = gid * WGM, gsz = (nM - fm) < WGM ? (nM - fm) : WGM;
        u.pm = fm + ((wgid % nig) % gsz); u.pn = (wgid % nig) / gsz; return true;
    }
    __device__ __forceinline__ void a_ready(const Unit&) const {}
    __device__ __forceinline__ void done(const Unit&) const {}
};

typedef float f32x2 __attribute__((ext_vector_type(2))); typedef __bf16 bf16x2_t __attribute__((ext_vector_type(2)));
__device__ __forceinline__ unsigned cvt_pk_bf16(float lo, float hi) { const f32x2 v = {lo, hi}; const bf16x2_t b = __builtin_convertvector(v, bf16x2_t); return __builtin_bit_cast(unsigned, b); }
constexpr int TOK = 32768;
constexpr float QSCALE = 0.125f * 1.4426950408889634f;
__device__ __forceinline__ float sigm(float x) { return __builtin_amdgcn_rcpf(1.0f + __builtin_amdgcn_exp2f(-1.4426950408889634f * x)); }
__device__ __forceinline__ u32x4 pack8(const f32x4& a, const f32x4& b) { u32x4 w; w.x = cvt_pk_bf16(a[0], a[1]); w.y = cvt_pk_bf16(a[2], a[3]); w.z = cvt_pk_bf16(b[0], b[1]); w.w = cvt_pk_bf16(b[2], b[3]); return w; }
__device__ __forceinline__ void unpack8(const u32x4& w, f32x4& a, f32x4& b) {
    a[0] = __uint_as_float(w.x << 16); a[1] = __uint_as_float(w.x & 0xffff0000u); a[2] = __uint_as_float(w.y << 16); a[3] = __uint_as_float(w.y & 0xffff0000u);
    b[0] = __uint_as_float(w.z << 16); b[1] = __uint_as_float(w.z & 0xffff0000u); b[2] = __uint_as_float(w.w << 16); b[3] = __uint_as_float(w.w & 0xffff0000u); }

struct EpiInProj {
    static constexpr bool PERM = true, AFTER_DRAIN = false;
    bf16_t* H; const float* bg;
    __device__ __forceinline__ void operator()(const f32x4 (&acc)[2][2][4][2], const Unit& u, int wr, int wc, int fr, int fq) const {
        const int row0 = u.pm * BM + wr * 64 + fr;
        if (u.pn < 12) {
            const int seg = u.pn >> 1; const float sc = (seg == 0 || seg == 3) ? QSCALE : 1.0f;
            bf16_t* base = H + (size_t)seg * ((size_t)TOK * 512);
            const int col0 = (u.pn & 1) * 256 + wc * 32 + 8 * fq;
#pragma unroll
            for (int ai = 0; ai < 2; ++ai)
#pragma unroll
                for (int m = 0; m < 4; ++m) { bf16_t* rowp = base + (size_t)(row0 + ai * HALF + m * 16) * 512 + col0;
#pragma unroll
                    for (int bj = 0; bj < 2; ++bj) { const f32x4 v0 = acc[ai][bj][m][0] * sc, v1 = acc[ai][bj][m][1] * sc; *(u32x4*)(rowp + bj * HALF) = pack8(v0, v1); } }
        } else {
            const int t = u.pn - 12, g = t >> 2;
            bf16_t* base = H + (size_t)6 * TOK * 512 + (size_t)g * ((size_t)TOK * 1024);
            const int col0 = (t & 3) * 256 + wc * 32 + 8 * fq;
            f32x4 bv[2][2];
#pragma unroll
            for (int bj = 0; bj < 2; ++bj)
#pragma unroll
                for (int n = 0; n < 2; ++n) bv[bj][n] = *(const f32x4*)(bg + g * 1024 + col0 + bj * HALF + 4 * n);
#pragma unroll
            for (int ai = 0; ai < 2; ++ai)
#pragma unroll
                for (int m = 0; m < 4; ++m) { bf16_t* rowp = base + (size_t)(row0 + ai * HALF + m * 16) * 1024 + col0;
#pragma unroll
                    for (int bj = 0; bj < 2; ++bj) { f32x4 v0 = acc[ai][bj][m][0] + bv[bj][0], v1 = acc[ai][bj][m][1] + bv[bj][1];
#pragma unroll
                        for (int e = 0; e < 4; ++e) { v0[e] = sigm(v0[e]); v1[e] = sigm(v1[e]); }
                        *(u32x4*)(rowp + bj * HALF) = pack8(v0, v1); } }
        }
    }
};
struct EpiGate {
    static constexpr bool PERM = true, AFTER_DRAIN = false;
    bf16_t* mix; const bf16_t* gate; int add;
    __device__ __forceinline__ void operator()(const f32x4 (&acc)[2][2][4][2], const Unit& u, int wr, int wc, int fr, int fq) const {
        const int row0 = u.pm * BM + wr * 64 + fr, col0 = u.pn * BM + wc * 32 + 8 * fq;
#pragma unroll
        for (int ai = 0; ai < 2; ++ai)
#pragma unroll
            for (int m = 0; m < 4; ++m) { const size_t off = (size_t)(row0 + ai * HALF + m * 16) * 1024 + col0;
#pragma unroll
                for (int bj = 0; bj < 2; ++bj) { const u32x4 gw = *(const u32x4*)(gate + off + bj * HALF); f32x4 g0, g1; unpack8(gw, g0, g1);
                    f32x4 v0 = g0 * acc[ai][bj][m][0], v1 = g1 * acc[ai][bj][m][1];
                    if (add) { const u32x4 mw = *(const u32x4*)(mix + off + bj * HALF); f32x4 m0, m1; unpack8(mw, m0, m1); v0 += m0; v1 += m1; }
                    *(u32x4*)(mix + off + bj * HALF) = pack8(v0, v1); } }
    }
};
struct EpiRes {
    static constexpr bool PERM = false, AFTER_DRAIN = false;
    const float* res; float* out; float alpha;
    __device__ __forceinline__ void operator()(const f32x4 (&acc)[2][2][4][2], const Unit& u, int wr, int wc, int fr, int fq) const {
        const int row0 = u.pm * BM + wr * 64 + fr, col0 = u.pn * BM + wc * 32 + 4 * fq;
#pragma unroll
        for (int ai = 0; ai < 2; ++ai)
#pragma unroll
            for (int m = 0; m < 4; ++m) { const size_t off = (size_t)(row0 + ai * HALF + m * 16) * 1024 + col0;
#pragma unroll
                for (int bj = 0; bj < 2; ++bj)
#pragma unroll
                    for (int n = 0; n < 2; ++n) { const f32x4 r = *(const f32x4*)(res + off + bj * HALF + n * 16); *(f32x4*)(out + off + bj * HALF + n * 16) = r * alpha + acc[ai][bj][m][n]; } }
    }
};
struct EpiSwiGLU {
    static constexpr bool PERM = true, AFTER_DRAIN = false;
    bf16_t* hf;
    __device__ __forceinline__ void operator()(const f32x4 (&acc)[2][2][4][2], const Unit& u, int wr, int wc, int fr, int fq) const {
        const int row0 = u.pm * BM + wr * 64 + fr, col0 = u.pn * HALF + wc * 32 + 8 * fq;
#pragma unroll
        for (int ai = 0; ai < 2; ++ai)
#pragma unroll
            for (int m = 0; m < 4; ++m) { bf16_t* rowp = hf + (size_t)(row0 + ai * HALF + m * 16) * 2816 + col0;
                f32x4 h0, h1;
#pragma unroll
                for (int e = 0; e < 4; ++e) { const float g0 = acc[ai][0][m][0][e], g1 = acc[ai][0][m][1][e];
                    h0[e] = g0 * sigm(g0) * acc[ai][1][m][0][e]; h1[e] = g1 * sigm(g1) * acc[ai][1][m][1][e]; }
                *(u32x4*)rowp = pack8(h0, h1); }
    }
};

template <class Epi, class Sched, bool ALIGN_EPI = false, bool SP2 = false>
__device__ __forceinline__ void gemm_phase(PG8_LAS unsigned char* lds, const Gemm g, const Sched& S, const Epi& E) {
    int tid_ = threadIdx.x; asm volatile("" : "+v"(tid_));
    const int tid = tid_, wid = __builtin_amdgcn_readfirstlane(tid >> 6), lane = tid & 63, wr = wid >> 2, wc = wid & 3, fr = lane & 15, fq = lane >> 4;
    const int K = g.K, nt = K / BK;
    unsigned voffA[2], voffB[2];
#pragma unroll
    for (int i = 0; i < 2; ++i) { int R, C; stage_rc(tid * 16 + i * 8192, R, C); const int Rb = Epi::PERM ? ((R & ~31) + perm32(R & 31)) : R;
        voffA[i] = (unsigned)(R * K + C) * 2u; voffB[i] = (unsigned)(Rb * K + C) * 2u; }
    const size_t kstep = (size_t)(BK * 2);
    const size_t hstep = (size_t)HALF * K * 2;
    const size_t tstep = 2 * hstep;
    const unsigned ldsw = (unsigned)wid * 1024u;
    const int aoff = lds_byte(wr * 64 + fr, fq * 8), boff = lds_byte(wc * 32 + fr, fq * 8);
#define PG8_SA(b, h) (((b) * 2 + (h)) * HTB)
#define PG8_SB(b, h) ((4 + (b) * 2 + (h)) * HTB)
#define PG8_STAGE(bufoff, gbase, voff) do { _Pragma("unroll") for (int _i = 0; _i < 2; ++_i) \
        __builtin_amdgcn_global_load_lds((const unsigned*)((const char*)(gbase) + (voff)[_i]), (PG8_LAS unsigned*)(lds + (bufoff) + ldsw + _i * 8192), 16, 0, 0); } while (0)
#define PG8_LDA(dst, b, h) do { _Pragma("unroll") for (int m = 0; m < 4; ++m) _Pragma("unroll") for (int k = 0; k < 2; ++k) dst[m][k] = *(const PG8_LAS bf16x8*)(lds + PG8_SA(b, h) + aoff + m * 2048 + k * 1024); } while (0)
#define PG8_LDB(dst, b, h) do { _Pragma("unroll") for (int n = 0; n < 2; ++n) _Pragma("unroll") for (int k = 0; k < 2; ++k) dst[n][k] = *(const PG8_LAS bf16x8*)(lds + PG8_SB(b, h) + boff + n * 2048 + k * 1024); } while (0)
#define PG8_MMA(ai, bj, At, Bt) do { __builtin_amdgcn_s_setprio(1); _Pragma("unroll") for (int m = 0; m < 4; ++m) _Pragma("unroll") for (int n = 0; n < 2; ++n) _Pragma("unroll") for (int k = 0; k < 2; ++k) \
        acc[ai][bj][m][n] = __builtin_amdgcn_mfma_f32_16x16x32_bf16(Bt[n][k], At[m][k], acc[ai][bj][m][n], 0, 0, 0); __builtin_amdgcn_s_setprio(0); } while (0)
#define PG8_WAIT_V(n) asm volatile("s_waitcnt vmcnt(" #n ")" ::: "memory")
#define PG8_WAIT_L(n) asm volatile("s_waitcnt lgkmcnt(" #n ")" ::: "memory")
#define PG8_BAR __builtin_amdgcn_s_barrier()
#define PG8_SCHED __builtin_amdgcn_sched_barrier(0)
    Unit cur, nxt; int ui = 0;
    if (!S.next(0, cur)) return;
    f32x4 acc[2][2][4][2];
#pragma unroll
    for (int a = 0; a < 2; ++a)
#pragma unroll
        for (int b = 0; b < 2; ++b)
#pragma unroll
            for (int m = 0; m < 4; ++m)
#pragma unroll
                for (int n = 0; n < 2; ++n) acc[a][b][m][n] = (f32x4){0.f, 0.f, 0.f, 0.f};
    bf16x8 At[4][2], B0[2][2], B1[2][2];
    const char* cA = (const char*)g.A + (size_t)cur.pm * tstep; const char* cB = (const char*)g.Bt + (size_t)cur.pn * tstep;
    S.a_ready(cur);
    if constexpr (SP2) {
        PG8_STAGE(PG8_SB(0, 0), cB, voffB); PG8_STAGE(PG8_SB(0, 1), cB + hstep, voffB); PG8_STAGE(PG8_SA(0, 0), cA, voffA); PG8_STAGE(PG8_SA(0, 1), cA + hstep, voffA);
        if (wr == 1) PG8_BAR;
        PG8_WAIT_V(2); PG8_BAR;
        PG8_STAGE(PG8_SB(1, 0), cB + kstep, voffB); PG8_STAGE(PG8_SA(1, 0), cA + kstep, voffA); PG8_STAGE(PG8_SB(1, 1), cB + hstep + kstep, voffB);
        PG8_WAIT_V(6); PG8_BAR;
    } else {
        PG8_STAGE(PG8_SB(0, 0), cB, voffB); PG8_STAGE(PG8_SA(0, 0), cA, voffA); PG8_STAGE(PG8_SB(0, 1), cB + hstep, voffB); PG8_STAGE(PG8_SA(0, 1), cA + hstep, voffA);
        if (wr == 1) PG8_BAR;
        PG8_WAIT_V(4); PG8_BAR;
        PG8_STAGE(PG8_SB(1, 0), cB + kstep, voffB); PG8_STAGE(PG8_SA(1, 0), cA + kstep, voffA); PG8_STAGE(PG8_SB(1, 1), cB + hstep + kstep, voffB);
        PG8_WAIT_V(6); PG8_BAR;
    }
    for (;;) {
        const bool has_next = S.next(ui + 1, nxt);
        const char* nA = has_next ? (const char*)g.A + (size_t)nxt.pm * tstep : cA; const char* nB = has_next ? (const char*)g.Bt + (size_t)nxt.pn * tstep : cB;
        for (int t = 0; t < nt; t += 2) {
            const bool last = (t == nt - 2);
            const char* a1 = cA + (size_t)(t + 1) * kstep;
            const char* a2 = last ? nA : cA + (size_t)(t + 2) * kstep; const char* b2 = last ? nB : cB + (size_t)(t + 2) * kstep;
            const char* a3 = a2 + kstep; const char* b3 = b2 + kstep;
            if (last && has_next) S.a_ready(nxt);
            if constexpr (SP2) {
            PG8_LDB(B0, 0, 0); PG8_LDB(B1, 0, 1); PG8_SCHED; PG8_LDA(At, 0, 0); PG8_STAGE(PG8_SA(1, 1), a1 + hstep, voffA);
            PG8_WAIT_V(8); PG8_WAIT_L(0); PG8_BAR; PG8_MMA(0, 0, At, B0); PG8_MMA(0, 1, At, B1); PG8_BAR; PG8_SCHED;
            PG8_LDA(At, 0, 1); PG8_STAGE(PG8_SB(0, 0), b2, voffB); PG8_STAGE(PG8_SB(0, 1), b2 + hstep, voffB); PG8_STAGE(PG8_SA(0, 0), a2, voffA);
            PG8_WAIT_V(8); PG8_WAIT_L(0); PG8_BAR; PG8_MMA(1, 0, At, B0); PG8_MMA(1, 1, At, B1); PG8_BAR; PG8_SCHED;
            PG8_LDB(B0, 1, 0); PG8_LDB(B1, 1, 1); PG8_SCHED; PG8_LDA(At, 1, 0); PG8_STAGE(PG8_SA(0, 1), a2 + hstep, voffA);
            PG8_WAIT_V(8); PG8_WAIT_L(0); PG8_BAR; PG8_MMA(0, 0, At, B0); PG8_MMA(0, 1, At, B1); PG8_BAR; PG8_SCHED;
            PG8_LDA(At, 1, 1); PG8_STAGE(PG8_SB(1, 0), b3, voffB); PG8_STAGE(PG8_SB(1, 1), b3 + hstep, voffB); PG8_STAGE(PG8_SA(1, 0), a3, voffA);
            PG8_WAIT_V(8); PG8_WAIT_L(0); PG8_BAR; PG8_MMA(1, 0, At, B0); PG8_MMA(1, 1, At, B1); PG8_BAR; PG8_SCHED;
            } else {
            PG8_LDB(B0, 0, 0); PG8_SCHED; PG8_LDA(At, 0, 0); PG8_STAGE(PG8_SA(1, 1), a1 + hstep, voffA);
            PG8_WAIT_L(8); PG8_BAR; PG8_WAIT_L(0); PG8_MMA(0, 0, At, B0); PG8_BAR; PG8_SCHED;
            PG8_LDB(B1, 0, 1); PG8_STAGE(PG8_SB(0, 0), b2, voffB);
            PG8_BAR; PG8_WAIT_L(0); PG8_MMA(0, 1, At, B1); PG8_BAR;
            PG8_LDA(At, 0, 1); PG8_STAGE(PG8_SA(0, 0), a2, voffA);
            PG8_BAR; PG8_WAIT_L(0); PG8_MMA(1, 0, At, B0); PG8_BAR; PG8_SCHED;
            PG8_STAGE(PG8_SB(0, 1), b2 + hstep, voffB);
            PG8_WAIT_V(6); PG8_BAR; PG8_MMA(1, 1, At, B1); PG8_BAR;
            PG8_LDB(B0, 1, 0); PG8_SCHED; PG8_LDA(At, 1, 0); PG8_STAGE(PG8_SA(0, 1), a2 + hstep, voffA);
            PG8_WAIT_L(8); PG8_BAR; PG8_WAIT_L(0); PG8_MMA(0, 0, At, B0); PG8_BAR; PG8_SCHED;
            PG8_LDB(B1, 1, 1); PG8_STAGE(PG8_SB(1, 0), b3, voffB);
            PG8_BAR; PG8_WAIT_L(0); PG8_MMA(0, 1, At, B1); PG8_BAR;
            PG8_LDA(At, 1, 1); PG8_STAGE(PG8_SA(1, 0), a3, voffA);
            PG8_BAR; PG8_WAIT_L(0); PG8_MMA(1, 0, At, B0); PG8_BAR; PG8_SCHED;
            PG8_STAGE(PG8_SB(1, 1), b3 + hstep, voffB);
            PG8_WAIT_V(6); PG8_BAR; PG8_MMA(1, 1, At, B1); PG8_BAR;
            }
        }
        if constexpr (ALIGN_EPI) { if (wr == 0) PG8_BAR; }
        if constexpr (!Epi::AFTER_DRAIN) { E(acc, cur, wr, wc, fr, fq); S.done(cur); }
        if (!has_next) break;
#pragma unroll
        for (int a = 0; a < 2; ++a)
#pragma unroll
            for (int b = 0; b < 2; ++b)
#pragma unroll
                for (int m = 0; m < 4; ++m)
#pragma unroll
                    for (int n = 0; n < 2; ++n) acc[a][b][m][n] = (f32x4){0.f, 0.f, 0.f, 0.f};
        cur = nxt; cA = nA; cB = nB; ++ui;
        if constexpr (ALIGN_EPI) { if (wr == 1) PG8_BAR; }
    }
    PG8_WAIT_V(0);
    if constexpr (!ALIGN_EPI) { if (wr == 0) PG8_BAR; }
    PG8_BAR;
    if constexpr (Epi::AFTER_DRAIN) { E.fused(acc, cur, wr, wc, fr, fq, lds, wid, lane); S.done(cur); }
#undef PG8_SA
#undef PG8_SB
#undef PG8_STAGE
#undef PG8_LDA
#undef PG8_LDB
#undef PG8_MMA
#undef PG8_WAIT_V
#undef PG8_WAIT_L
#undef PG8_BAR
#undef PG8_SCHED
}
}
namespace att {
#define ALDS __attribute__((address_space(3)))
typedef unsigned short bf16;
typedef short bf16x8 __attribute__((ext_vector_type(8)));
typedef short s16x4 __attribute__((ext_vector_type(4)));
typedef short v4i16_t __attribute__((ext_vector_type(4)));
typedef float f32x16 __attribute__((ext_vector_type(16)));
typedef unsigned u32x4 __attribute__((ext_vector_type(4)));
typedef unsigned u32x2 __attribute__((ext_vector_type(2)));
constexpr int SEQ = 8192, PITCH = 512;
constexpr int KS_OFF = 0, KS_PITCH = 144, VS_OFF = 9216, BIAS_OFF = 17408, FLAG_OFF = 19472, ATT_LDS = 19472 + 64;
__device__ __forceinline__ int crow(int r, int hi) { return (r & 3) + 8 * (r >> 2) + 4 * hi; }
typedef float f32x2_t __attribute__((ext_vector_type(2))); typedef __bf16 bf16x2_t __attribute__((ext_vector_type(2)));
__device__ __forceinline__ unsigned cvtpk(float lo, float hi) { const f32x2_t v = {lo, hi}; const bf16x2_t b = __builtin_convertvector(v, bf16x2_t); return __builtin_bit_cast(unsigned, b); }
__device__ __forceinline__ s16x4 vtr(ALDS const unsigned char* p) { return __builtin_bit_cast(s16x4, __builtin_amdgcn_ds_read_tr16_b64_v4i16((ALDS v4i16_t*)p)); }
__device__ __forceinline__ float swap_sum(float x) { auto rr = __builtin_amdgcn_permlane32_swap(__float_as_uint(x), __float_as_uint(x), false, false); return __uint_as_float(rr[0]) + __uint_as_float(rr[1]); }
__device__ __forceinline__ float swap_max(float x) { auto rr = __builtin_amdgcn_permlane32_swap(__float_as_uint(x), __float_as_uint(x), false, false); return fmaxf(__uint_as_float(rr[0]), __uint_as_float(rr[1])); }

struct KVRegs { u32x4 k, v; };
__device__ __forceinline__ void kv_load(KVRegs& R, const bf16* Kh, const bf16* Vh, long row0, int tid) {
    const size_t off = (size_t)(row0 + (tid >> 3)) * PITCH + (tid & 7) * 8;
    R.k = *(const u32x4*)(Kh + off); R.v = *(const u32x4*)(Vh + off);
}
__device__ __forceinline__ void kv_store(const KVRegs& R, ALDS unsigned char* lds, int tid) {
    const int row = tid >> 3, ch = tid & 7;
    *(ALDS u32x4*)(lds + KS_OFF + row * KS_PITCH + ch * 16) = R.k;
    *(ALDS u32x4*)(lds + VS_OFF + (ch >> 2) * 4096 + row * 64 + (ch & 3) * 16) = R.v;
}
__device__ __forceinline__ void qk_tile(f32x16& p0, f32x16& p1, ALDS const unsigned char* lds, const bf16x8 (&qf)[4], int r32, int hi) {
    ALDS const unsigned char* kb = lds + KS_OFF + r32 * KS_PITCH + hi * 16;
    p0 = f32x16{}; p1 = f32x16{};
#pragma unroll
    for (int ks = 0; ks < 4; ++ks) {
        const bf16x8 a0 = *(ALDS const bf16x8*)(kb + ks * 32);
        const bf16x8 a1 = *(ALDS const bf16x8*)(kb + 32 * KS_PITCH + ks * 32);
        p0 = __builtin_amdgcn_mfma_f32_32x32x16_bf16(a0, qf[ks], p0, 0, 0, 0);
        p1 = __builtin_amdgcn_mfma_f32_32x32x16_bf16(a1, qf[ks], p1, 0, 0, 0);
    }
}
__device__ __forceinline__ void pv_tile(f32x16 (&o)[2], ALDS const unsigned char* lds, const f32x16& p0, const f32x16& p1, int lane, int hi) {
    ALDS const unsigned char* vp = lds + VS_OFF + ((lane >> 4) & 1) * 32 + (lane & 3) * 8 + (4 * hi + ((lane & 15) >> 2)) * 64;
#pragma unroll
    for (int ks = 0; ks < 4; ++ks) {
        const f32x16& P = (ks < 2) ? p0 : p1; const int b = (ks & 1) * 8;
        u32x4 pw; pw.x = cvtpk(P[b], P[b + 1]); pw.y = cvtpk(P[b + 2], P[b + 3]); pw.z = cvtpk(P[b + 4], P[b + 5]); pw.w = cvtpk(P[b + 6], P[b + 7]);
        const bf16x8 pf = __builtin_bit_cast(bf16x8, pw);
#pragma unroll
        for (int d0 = 0; d0 < 2; ++d0) {
            const s16x4 lo = vtr(vp + d0 * 4096 + ks * 1024), h4 = vtr(vp + d0 * 4096 + ks * 1024 + 512);
            const bf16x8 vf = (bf16x8){lo[0], lo[1], lo[2], lo[3], h4[0], h4[1], h4[2], h4[3]};
            o[d0] = __builtin_amdgcn_mfma_f32_32x32x16_bf16(vf, pf, o[d0], 0, 0, 0);
        }
    }
}
__device__ __forceinline__ void load_q(bf16x8 (&qf)[4], const bf16* Qrow, int hi) {
#pragma unroll
    for (int ks = 0; ks < 4; ++ks) qf[ks] = *(const bf16x8*)(Qrow + ks * 16 + hi * 8);
}
__device__ __forceinline__ void store_o(bf16* Orow, const f32x16 (&o)[2], int hi, float s) {
#pragma unroll
    for (int d0 = 0; d0 < 2; ++d0)
#pragma unroll
        for (int g = 0; g < 4; ++g) { u32x2 w; w.x = cvtpk(o[d0][4 * g] * s, o[d0][4 * g + 1] * s); w.y = cvtpk(o[d0][4 * g + 2] * s, o[d0][4 * g + 3] * s);
            *(u32x2*)(Orow + 32 * d0 + 8 * g + 4 * hi) = w; }
}

__device__ __forceinline__ void band_unit(int b, int h, int cgp, const bf16* Q, const bf16* K, const bf16* V, bf16* O, const float* relb, ALDS unsigned char* lds) {
    int tid_ = threadIdx.x; asm volatile("" : "+v"(tid_));
    const int tid = tid_, lane = tid & 63, r32 = lane & 31, hi = lane >> 5, wid = __builtin_amdgcn_readfirstlane(tid >> 6);
    ALDS float* biasL = (ALDS float*)(lds + BIAS_OFF);
    __syncthreads();
    for (int i = tid; i < 513; i += 512) biasL[i] = relb[i] * 1.4426950408889634f;
    const long rowbase = (long)b * SEQ; const int qw = 256 * cgp + 32 * wid, c = 4 * cgp + (wid >> 1);
    const bf16* Kh = K + h * 64; const bf16* Vh = V + h * 64;
    bf16x8 qf[4]; load_q(qf, Q + (size_t)(rowbase + qw + r32) * PITCH + h * 64, hi);
    float mrun = -1e30f, lrun = 0.f; f32x16 o[2]; o[0] = f32x16{}; o[1] = f32x16{};
    const int jlo = (4 * cgp - 8 > 0) ? 4 * cgp - 8 : 0, jhi = 4 * cgp + 3;
    KVRegs R; kv_load(R, Kh, Vh, rowbase + 64 * jlo, tid);
    for (int jc = jlo; jc <= jhi; ++jc) {
        __syncthreads();
        kv_store(R, lds, tid);
        if (jc < jhi) kv_load(R, Kh, Vh, rowbase + 64 * (jc + 1), tid);
        __syncthreads();
        if (jc >= c - 8 && jc <= c) {
            f32x16 p0, p1; qk_tile(p0, p1, lds, qf, r32, hi);
            const int tb = qw + r32 - 64 * jc + 256;
            float mx = -1e30f;
#pragma unroll
            for (int r = 0; r < 16; ++r) { const int i0 = tb - crow(r, hi), i1 = i0 - 32;
                p0[r] += biasL[i0 < 512 ? i0 : 512]; p1[r] += biasL[i1 < 512 ? i1 : 512]; mx = fmaxf(mx, fmaxf(p0[r], p1[r])); }
            mx = swap_max(mx);
            const float mnew = fmaxf(mrun, mx), al = __builtin_amdgcn_exp2f(mrun - mnew); mrun = mnew;
            float rs = 0.f;
#pragma unroll
            for (int r = 0; r < 16; ++r) { p0[r] = __builtin_amdgcn_exp2f(p0[r] - mnew); p1[r] = __builtin_amdgcn_exp2f(p1[r] - mnew); rs += p0[r] + p1[r]; }
            lrun = lrun * al + rs;
#pragma unroll
            for (int r = 0; r < 16; ++r) { o[0][r] *= al; o[1][r] *= al; }
            pv_tile(o, lds, p0, p1, lane, hi);
        }
    }
    const float inv = 1.0f / swap_sum(lrun);
    store_o(O + (size_t)(rowbase + qw + r32) * PITCH + h * 64, o, hi, inv);
}

__device__ __forceinline__ void stick_unit(int b, int h, int qb, const bf16* Q, const bf16* K, const bf16* V, bf16* O, ALDS unsigned char* lds) {
    int tid_ = threadIdx.x; asm volatile("" : "+v"(tid_));
    const int tid = tid_, lane = tid & 63, r32 = lane & 31, hi = lane >> 5, wid = __builtin_amdgcn_readfirstlane(tid >> 6);
    ALDS volatile unsigned* flag = (ALDS volatile unsigned*)(lds + FLAG_OFF);
    const long rowbase = (long)b * SEQ; const int qw = 256 * qb + 32 * wid, t = qw + r32;
    const bf16* Kh = K + h * 64; const bf16* Vh = V + h * 64;
    bf16x8 qf[4]; load_q(qf, Q + (size_t)(rowbase + t) * PITCH + h * 64, hi);
    float carry = 0.f; f32x16 o[2]; o[0] = f32x16{}; o[1] = f32x16{};
    const float lomask = hi ? 0.f : 1.f;
    const int jt = 4 * qb + 3;
    KVRegs R; kv_load(R, Kh, Vh, rowbase + 64 * jt, tid);
    __syncthreads();
    for (int j = jt; j >= 0; --j) {
        __syncthreads();
        if (j < jt) { unsigned all = 1u;
#pragma unroll
            for (int w = 0; w < 8; ++w) all &= flag[w];
            if (all) break; }
        kv_store(R, lds, tid);
        if (j > 0) kv_load(R, Kh, Vh, rowbase + 64 * (j - 1), tid);
        __syncthreads();
        const int k0 = 64 * j; unsigned done = 0u;
        if (k0 <= qw + 30) {
            f32x16 p0, p1, L0, L1; qk_tile(p0, p1, lds, qf, r32, hi);
#pragma unroll
            for (int r = 0; r < 16; ++r) {
                { const float y = p0[r], lg = __builtin_amdgcn_logf(1.0f + __builtin_amdgcn_exp2f(-fabsf(y))); p0[r] = fminf(y, 0.f) - lg; L0[r] = fminf(-y, 0.f) - lg; }
                { const float y = p1[r], lg = __builtin_amdgcn_logf(1.0f + __builtin_amdgcn_exp2f(-fabsf(y))); p1[r] = fminf(y, 0.f) - lg; L1[r] = fminf(-y, 0.f) - lg; }
            }
            if (k0 + 63 >= qw) {
#pragma unroll
                for (int r = 0; r < 16; ++r) { const int kv = k0 + crow(r, hi);
                    if (kv >= t) { p0[r] = -1e30f; L0[r] = 0.f; }
                    if (kv + 32 >= t) { p1[r] = -1e30f; L1[r] = 0.f; } }
            }
            float T[8], H[8];
#pragma unroll
            for (int i = 0; i < 4; ++i) { const float g0 = (L0[4 * i] + L0[4 * i + 1]) + (L0[4 * i + 2] + L0[4 * i + 3]), g1 = (L1[4 * i] + L1[4 * i + 1]) + (L1[4 * i + 2] + L1[4 * i + 3]);
                T[i] = swap_sum(g0); H[i] = T[i] - g0; T[4 + i] = swap_sum(g1); H[4 + i] = T[4 + i] - g1; }
            float A = 0.f;
#pragma unroll
            for (int i = 7; i >= 4; --i) { const int bq = 4 * (i - 4); const float s3 = carry + A + lomask * H[i], s2 = s3 + L1[bq + 3], s1 = s2 + L1[bq + 2], s0 = s1 + L1[bq + 1];
                p1[bq + 3] = __builtin_amdgcn_exp2f(p1[bq + 3] + s3); p1[bq + 2] = __builtin_amdgcn_exp2f(p1[bq + 2] + s2); p1[bq + 1] = __builtin_amdgcn_exp2f(p1[bq + 1] + s1); p1[bq] = __builtin_amdgcn_exp2f(p1[bq] + s0);
                A += T[i]; }
#pragma unroll
            for (int i = 3; i >= 0; --i) { const int bq = 4 * i; const float s3 = carry + A + lomask * H[i], s2 = s3 + L0[bq + 3], s1 = s2 + L0[bq + 2], s0 = s1 + L0[bq + 1];
                p0[bq + 3] = __builtin_amdgcn_exp2f(p0[bq + 3] + s3); p0[bq + 2] = __builtin_amdgcn_exp2f(p0[bq + 2] + s2); p0[bq + 1] = __builtin_amdgcn_exp2f(p0[bq + 1] + s1); p0[bq] = __builtin_amdgcn_exp2f(p0[bq] + s0);
                A += T[i]; }
            carry += A;
            pv_tile(o, lds, p0, p1, lane, hi);
            done = __all(carry < -160.0f) ? 1u : 0u;
        }
        if (lane == 0) flag[wid] = done;
    }
    store_o(O + (size_t)(rowbase + t) * PITCH + h * 64, o, hi, 1.0f);
}
#undef ALDS
}

#include <hip/hip_cooperative_groups.h>
namespace cg = cooperative_groups;
#define LAS __attribute__((address_space(3)))
typedef unsigned short bf16;
typedef unsigned v4u __attribute__((ext_vector_type(4)));
typedef unsigned v2u __attribute__((ext_vector_type(2)));
typedef float f32x4 __attribute__((ext_vector_type(4)));

constexpr int NWAVES = 8, NTHR = 512;
constexpr int BATCH = 4, SEQ = 8192, M = BATCH * SEQ, D = 1024, DEPTH = 2, WA = 512, NIN = 5120, DFF = 2816, NFF = 2 * DFF, NREL = 513;
constexpr float DN_ALPHA = 1.4142135623730951f;
constexpr float LN_EPS = 1e-5f;
static_assert(M == pg8::TOK, "token rows");
constexpr size_t MiB = 1u << 20;
constexpr size_t WS_CTL = 0, CTL_ZERO_BYTES = 16384;
constexpr size_t WS_W = 1 * MiB, W_LAYER = 31 * MiB;
constexpr size_t OW_IN = 0, OW_PA = 10 * MiB, OW_PB = 11 * MiB, OW_OUT = 12 * MiB, OW_FI = 14 * MiB, OW_FO = 25 * MiB;
constexpr size_t WS_XB = 64 * MiB;
constexpr size_t WS_H = 128 * MiB;
constexpr size_t WS_R = 128 * MiB;
constexpr size_t WS_HF = 256 * MiB;
constexpr size_t WS_END = 448 * MiB;
static_assert(WS_W + 2 * W_LAYER <= WS_XB && WS_HF + (size_t)M * DFF * 2 <= WS_END && OW_FO + (size_t)D * DFF * 2 <= W_LAYER, "d_ws map");
constexpr int RING_BYTES = 131072, MISC_OFF = RING_BYTES, LDS_BYTES = 147456;
static_assert(att::ATT_LDS <= RING_BYTES, "attention scratch inside the ring");

__device__ __forceinline__ unsigned f2bf(float f) { unsigned u = __builtin_bit_cast(unsigned, f); return (u + 0x7fffu + ((u >> 16) & 1u)) >> 16; }
__device__ __forceinline__ unsigned pk2(float lo, float hi) { return f2bf(lo) | (f2bf(hi) << 16); }
__device__ __forceinline__ float wave_sum(float v) {
#pragma unroll
    for (int o = 1; o < 64; o <<= 1) v += __shfl_xor(v, o);
    return v;
}
template <bool FFI>
__device__ __forceinline__ void transpose_item(const float* W, int K, int N, bf16* WT, LAS float* scr, int item, int lane) {
    const int nblk = N / 32, kb = item / nblk, nb = item % nblk, k0 = 64 * kb, n0 = 32 * nb;
#pragma unroll 8
    for (int i = 0; i < 32; ++i) { const int kk = 2 * i + (lane >> 5); scr[kk * 33 + (lane & 31)] = W[(size_t)(k0 + kk) * N + n0 + (lane & 31)]; }
    asm volatile("s_waitcnt lgkmcnt(0)" ::: "memory");
    int r0 = n0;
    if (FFI) { const int half = n0 >= DFF, nn = half ? n0 - DFF : n0; r0 = 256 * (nn / 128) + 128 * half + (nn % 128); }
    const int c = lane & 7;
#pragma unroll
    for (int j = 0; j < 4; ++j) { const int n = (lane >> 3) + 8 * j; const LAS float* s = scr + (8 * c) * 33 + n;
        v4u o; o.x = pk2(s[0 * 33], s[1 * 33]); o.y = pk2(s[2 * 33], s[3 * 33]); o.z = pk2(s[4 * 33], s[5 * 33]); o.w = pk2(s[6 * 33], s[7 * 33]);
        *(v4u*)(WT + (size_t)(r0 + n) * K + k0 + 8 * c) = o; }
    asm volatile("s_waitcnt lgkmcnt(0)" ::: "memory");
}
#define RLX_AGENT __ATOMIC_RELAXED, __HIP_MEMORY_SCOPE_AGENT
#define XB_TMO      128
#define XB_XCNT(j)  (256  + 64 * (j))
#define XB_XSUB(j)  (1280 + 64 * (j))
#define XB_XGEN(j)  (2304 + 64 * (j))
#define XB_TOP      3328
#define XB_TOPGEN   3392
#define XCD_BAR_WORDS 3456
#define XB_SPIN_CAP (1u << 18)

__device__ __forceinline__ unsigned xb_ld(unsigned* p)              { return __hip_atomic_load(p, __ATOMIC_RELAXED, __HIP_MEMORY_SCOPE_AGENT); }
__device__ __forceinline__ unsigned xb_add(unsigned* p, unsigned v) { return __hip_atomic_fetch_add(p, v, __ATOMIC_RELAXED, __HIP_MEMORY_SCOPE_AGENT); }
__device__ __forceinline__ unsigned xb_xcc_id() { return (unsigned)__builtin_amdgcn_s_getreg((3 << 11) | 20) & 0xFu; }
#define XB_SPIN(cond, bar) do { unsigned _sp = 0; while (cond) { __builtin_amdgcn_s_sleep(1); \
    if ((++_sp & 255u) == 0u) { if (xb_ld(&(bar)[XB_TMO])) break; if (_sp > XB_SPIN_CAP) { atomicAdd(&(bar)[XB_TMO], 1u); break; } } } } while (0)

struct XcdBarrier {
    unsigned* bar; unsigned x;
    volatile LAS unsigned* st;
};

__device__ __forceinline__ XcdBarrier xcd_barrier_post(unsigned* bar, volatile LAS unsigned* st) {
    XcdBarrier b; b.bar = bar; b.x = xb_xcc_id(); b.st = st;
    if (threadIdx.x == 0) (void)xb_add(&bar[XB_XCNT(b.x)], 1u);
    return b;
}
__device__ __forceinline__ void xcd_barrier_complete(unsigned* bar, unsigned x, unsigned& nloc, unsigned& nx) {
    const unsigned G = gridDim.x * gridDim.y * gridDim.z;
    unsigned sum, cnt, mine, sp = 0u;
    for (;;) {
        sum = 0u; cnt = 0u; mine = 0u;
#pragma unroll
        for (unsigned j = 0; j < 16; ++j) { const unsigned c = xb_ld(&bar[XB_XCNT(j)]); sum += c; cnt += (c > 0u) ? 1u : 0u; mine = (j == x) ? c : mine; }
        if (sum == G) break;
        __builtin_amdgcn_s_sleep(1);
        if ((++sp & 255u) == 0u) { if (xb_ld(&bar[XB_TMO])) break; if (sp > XB_SPIN_CAP) { atomicAdd(&bar[XB_TMO], 1u); break; } }
    }
    nloc = mine > 0u ? mine : 1u; nx = cnt > 0u ? cnt : 1u;
}

__device__ __forceinline__ void xcd_barrier(const XcdBarrier& b) {
    asm volatile("s_waitcnt vmcnt(0)" ::: "memory");
    __syncthreads();
    if (threadIdx.x == 0) {
        unsigned* bar = b.bar;
        __builtin_amdgcn_s_waitcnt(0);
        unsigned nloc = b.st[0], nx = b.st[1];
        if (nloc == 0u) { xcd_barrier_complete(bar, b.x, nloc, nx); b.st[0] = nloc; b.st[1] = nx; }
        const unsigned old = xb_add(&bar[XB_XSUB(b.x)], 1u);
        const unsigned gen = old / nloc;
        if (old + 1u == (gen + 1u) * nloc) {
            __builtin_amdgcn_fence(__ATOMIC_RELEASE, "agent");
            asm volatile("s_waitcnt vmcnt(0)" ::: "memory");
            const unsigned og = xb_add(&bar[XB_TOP], 1u);
            const unsigned tg = og / nx;
            if (og + 1u == (tg + 1u) * nx) xb_add(&bar[XB_TOPGEN], 1u);
            else XB_SPIN(xb_ld(&bar[XB_TOPGEN]) == tg, bar);
            __builtin_amdgcn_fence(__ATOMIC_ACQUIRE, "agent");
            xb_add(&bar[XB_XGEN(b.x)], 1u);
            asm volatile("s_waitcnt vmcnt(0)" ::: "memory");
        } else {
            XB_SPIN(xb_ld(&bar[XB_XGEN(b.x)]) == gen, bar);
            __builtin_amdgcn_fence(__ATOMIC_ACQUIRE, "agent");
            asm volatile("s_waitcnt vmcnt(0)" ::: "memory");
        }
    }
    __syncthreads();
}

struct Args { const float* in[13]; float* out; unsigned char* ws; int ph_lo, ph_hi; };
constexpr int N_PHASES = 1 + 8 * DEPTH;

__global__ void __launch_bounds__(NTHR, 2) mk_fwd(Args args) {
    extern __shared__ __attribute__((aligned(16))) unsigned char lds_raw[];
    LAS unsigned char* lds = (LAS unsigned char*)lds_raw;
    const int G = gridDim.x, bx = blockIdx.x;
    unsigned char* ws = args.ws;
    const float* x_in = args.in[0];
    bf16* XB = (bf16*)(ws + WS_XB); bf16* Oa = XB; bf16* Ob = XB + (size_t)M * WA;
    bf16* Hb = (bf16*)(ws + WS_H);
    bf16 *Qa = Hb, *Ka = Hb + (size_t)1 * M * WA, *Va = Hb + (size_t)2 * M * WA, *Qb = Hb + (size_t)3 * M * WA, *Kb = Hb + (size_t)4 * M * WA, *Vb = Hb + (size_t)5 * M * WA;
    bf16 *Ga = Hb + (size_t)6 * M * WA, *Gb = Ga + (size_t)M * D;
    float* Rb = (float*)(ws + WS_R); bf16* HF = (bf16*)(ws + WS_HF);
    float* XF = args.out;
    cg::grid_group grid = cg::this_grid();
    volatile LAS unsigned* MISC = (volatile LAS unsigned*)(lds + MISC_OFF);
    if (threadIdx.x < 32) MISC[threadIdx.x] = 0u;
    __syncthreads();
    XcdBarrier bar = xcd_barrier_post((unsigned*)(ws + WS_CTL), MISC + 8);

    for (int ph = args.ph_lo; ph < args.ph_hi; ++ph) {
        int tid_ = threadIdx.x; asm volatile("" : "+v"(tid_));
        const int tid = tid_, lane = tid & 63, wave = __builtin_amdgcn_readfirstlane(tid >> 6);
        const int gw = bx * NWAVES + wave, NGW = G * NWAVES;
        if (ph == 0) {
            LAS float* scr = (LAS float*)(lds + wave * 16384);
            for (int l = 0; l < DEPTH; ++l) {
                unsigned char* wl = ws + WS_W + (size_t)l * W_LAYER;
                constexpr int I_IN = (D / 64) * (NIN / 32), I_P = (WA / 64) * (D / 32), I_O = (D / 64) * (D / 32), I_FI = (D / 64) * (NFF / 32), I_FO = (DFF / 64) * (D / 32);
                constexpr int NIT = I_IN + 2 * I_P + I_O + I_FI + I_FO;
                for (int it = gw; it < NIT; it += NGW) {
                    int r = it;
                    if (r < I_IN) { transpose_item<false>(args.in[1] + (size_t)l * D * NIN, D, NIN, (bf16*)(wl + OW_IN), scr, r, lane); continue; } r -= I_IN;
                    if (r < I_P) { transpose_item<false>(args.in[4] + (size_t)l * WA * D, WA, D, (bf16*)(wl + OW_PA), scr, r, lane); continue; } r -= I_P;
                    if (r < I_P) { transpose_item<false>(args.in[5] + (size_t)l * WA * D, WA, D, (bf16*)(wl + OW_PB), scr, r, lane); continue; } r -= I_P;
                    if (r < I_O) { transpose_item<false>(args.in[6] + (size_t)l * D * D, D, D, (bf16*)(wl + OW_OUT), scr, r, lane); continue; } r -= I_O;
                    if (r < I_FI) { transpose_item<true>(args.in[9] + (size_t)l * D * NFF, D, NFF, (bf16*)(wl + OW_FI), scr, r, lane); continue; } r -= I_FI;
                    transpose_item<false>(args.in[10] + (size_t)l * DFF * D, DFF, D, (bf16*)(wl + OW_FO), scr, r, lane);
                }
            }
            for (size_t i = (size_t)bx * NTHR + tid; i < (size_t)M * D / 8; i += (size_t)G * NTHR) {
                const f32x4 a = *(const f32x4*)(x_in + 8 * i), b = *(const f32x4*)(x_in + 8 * i + 4);
                v4u o; o.x = pk2(a[0], a[1]); o.y = pk2(a[2], a[3]); o.z = pk2(b[0], b[1]); o.w = pk2(b[2], b[3]);
                *(v4u*)(XB + 8 * i) = o;
            }
        } else {
            const int l = (ph - 1) >> 3, sp = (ph - 1) & 7;
            unsigned char* wl = ws + WS_W + (size_t)l * W_LAYER;
            if (sp == 0) {
                pg8::Gemm g{XB, (const bf16*)(wl + OW_IN), M, NIN, D}; pg8::StaticOrder S; S.init(M, NIN, G, bx);
                pg8::EpiInProj E{Hb, args.in[2] + (size_t)l * 2 * D};
                pg8::gemm_phase<pg8::EpiInProj, pg8::StaticOrder, true, true>(lds, g, S, E);
            } else if (sp == 1) {
                const float* relb = args.in[3] + (size_t)l * 8 * NREL;
                for (int u = bx; u < 2048; u += G) {
                    const int idx = u & 1023, blk = idx & 31, h = (idx >> 5) & 7, b = idx >> 8;
                    if (u < 1024) att::band_unit(b, h, blk, Qa, Ka, Va, Oa, relb + h * NREL, lds);
                    else att::stick_unit(b, h, blk, Qb, Kb, Vb, Ob, lds);
                }
                __syncthreads();
            } else if (sp == 2) {
                { pg8::Gemm g{Oa, (const bf16*)(wl + OW_PA), M, D, WA}; pg8::StaticOrder S; S.init(M, D, G, bx);
                  pg8::EpiGate E{Ga, Ga, 0};
                  pg8::gemm_phase<pg8::EpiGate, pg8::StaticOrder, true, true>(lds, g, S, E); }
                { pg8::Gemm g{Ob, (const bf16*)(wl + OW_PB), M, D, WA}; pg8::StaticOrder S; S.init(M, D, G, bx);
                  pg8::EpiGate E{Ga, Gb, 1};
                  pg8::gemm_phase<pg8::EpiGate, pg8::StaticOrder, true, true>(lds, g, S, E); }
            } else if (sp == 3) {
                pg8::Gemm g{Ga, (const bf16*)(wl + OW_OUT), M, D, D}; pg8::StaticOrder S; S.init(M, D, G, bx);
                pg8::EpiRes E{l == 0 ? x_in : (const float*)XF, Rb, DN_ALPHA};
                pg8::gemm_phase<pg8::EpiRes, pg8::StaticOrder, true, true>(lds, g, S, E);
            } else if (sp == 4 || sp == 7) {
                const float* gam = args.in[sp == 4 ? 7 : 11] + (size_t)l * D; const float* bet = args.in[sp == 4 ? 8 : 12] + (size_t)l * D;
                f32x4 gv[4], bv[4];
#pragma unroll
                for (int j = 0; j < 4; ++j) { gv[j] = *(const f32x4*)(gam + 4 * lane + 256 * j); bv[j] = *(const f32x4*)(bet + 4 * lane + 256 * j); }
                for (int m = gw; m < M; m += NGW) {
                    const float* rr = Rb + (size_t)m * D + 4 * lane;
                    f32x4 v[4]; float s = 0.f;
#pragma unroll
                    for (int j = 0; j < 4; ++j) { v[j] = *(const f32x4*)(rr + 256 * j); s += (v[j][0] + v[j][1]) + (v[j][2] + v[j][3]); }
                    const float mean = wave_sum(s) * (1.f / D); float s2 = 0.f;
#pragma unroll
                    for (int j = 0; j < 4; ++j) { v[j] = v[j] - mean; s2 += (v[j][0] * v[j][0] + v[j][1] * v[j][1]) + (v[j][2] * v[j][2] + v[j][3] * v[j][3]); }
                    const float rstd = 1.f / sqrtf(wave_sum(s2) * (1.f / D) + LN_EPS);
#pragma unroll
                    for (int j = 0; j < 4; ++j) { const f32x4 y = v[j] * rstd * gv[j] + bv[j];
                        *(f32x4*)(XF + (size_t)m * D + 4 * lane + 256 * j) = y;
                        v2u o; o.x = pk2(y[0], y[1]); o.y = pk2(y[2], y[3]); *(v2u*)(XB + (size_t)m * D + 4 * lane + 256 * j) = o; }
                }
            } else if (sp == 5) {
                pg8::Gemm g{XB, (const bf16*)(wl + OW_FI), M, NFF, D}; pg8::StaticOrder S; S.init(M, NFF, G, bx);
                pg8::EpiSwiGLU E{HF};
                pg8::gemm_phase<pg8::EpiSwiGLU, pg8::StaticOrder, true, true>(lds, g, S, E);
            } else {
                pg8::Gemm g{HF, (const bf16*)(wl + OW_FO), M, D, DFF}; pg8::StaticOrder S; S.init(M, D, G, bx);
                pg8::EpiRes E{(const float*)XF, Rb, DN_ALPHA};
                pg8::gemm_phase<pg8::EpiRes, pg8::StaticOrder, true, true>(lds, g, S, E);
            }
        }
        if (ph + 1 < args.ph_hi) { if (args.ph_hi > 1000) grid.sync(); else xcd_barrier(bar); }
    }
}

#ifndef MK_MULTI
#define MK_MULTI 0
#endif
extern "C" void kernel_launch(void* const* d_in, const int* in_sizes, int n_in, void* d_out, int out_size, void* d_ws, size_t ws_size, hipStream_t stream) {
    static int grid = 0;
    if (grid == 0) {
        if (n_in != 13 || in_sizes[0] != M * D || out_size != M * D || ws_size < WS_END) { fprintf(stderr, "kernel_launch: unexpected shapes (n_in %d, in0 %d, out %d, ws %zu); nothing launched\n", n_in, n_in > 0 ? in_sizes[0] : -1, out_size, ws_size); grid = -1; return; }
        int dev = 0, cus = 0, per_cu = 0;
        if (hipGetDevice(&dev) != hipSuccess || hipDeviceGetAttribute(&cus, hipDeviceAttributeMultiprocessorCount, dev) != hipSuccess) { grid = -1; return; }
        if (hipFuncSetAttribute((const void*)mk_fwd, hipFuncAttributeMaxDynamicSharedMemorySize, LDS_BYTES) != hipSuccess) { fprintf(stderr, "kernel_launch: hipFuncSetAttribute failed\n"); grid = -1; return; }
        if (hipOccupancyMaxActiveBlocksPerMultiprocessor(&per_cu, (const void*)mk_fwd, NTHR, LDS_BYTES) != hipSuccess || per_cu < 1) { fprintf(stderr, "kernel_launch: occupancy query says %d\n", per_cu); per_cu = 1; }
        (void)hipGetLastError();
        grid = cus * 1;
    }
    if (grid < 0) return;
    if (hipMemsetAsync((char*)d_ws + WS_CTL, 0, CTL_ZERO_BYTES, stream) != hipSuccess) { fprintf(stderr, "kernel_launch: hipMemsetAsync failed\n"); return; }
    Args a{};
    for (int i = 0; i < 13; ++i) a.in[i] = (const float*)d_in[i];
    a.out = (float*)d_out; a.ws = (unsigned char*)d_ws;
#if MK_MULTI
    for (int ph = 0; ph < N_PHASES; ++ph) { a.ph_lo = ph; a.ph_hi = ph + 1; hipLaunchKernelGGL(mk_fwd, dim3(grid), dim3(NTHR), LDS_BYTES, stream, a); }
#else
    a.ph_lo = 0; a.ph_hi = N_PHASES;
    void* kargs[] = {&a};
    hipError_t e = hipLaunchCooperativeKernel((const void*)mk_fwd, dim3(grid), dim3(NTHR), kargs, LDS_BYTES, stream);
    if (e != hipSuccess) fprintf(stderr, "kernel_launch: cooperative launch failed: %s (grid %d)\n", hipGetErrorString(e), grid);
#endif
}
```

```cpp
#include <hip/hip_runtime.h>
#include <cstdio>
#include <cstdint>
namespace pg8 {
#define PG8_LAS __attribute__((address_space(3)))
typedef unsigned short bf16_t;
typedef short bf16x8 __attribute__((ext_vector_type(8)));
typedef float f32x4 __attribute__((ext_vector_type(4)));
typedef unsigned u32x4 __attribute__((ext_vector_type(4)));
constexpr int BM = 256, BK = 64, HALF = 128, HTB = HALF * BK * 2  , STAGE_BYTES = 8 * HTB, NXCD = 8, WGM = 8;

__host__ __device__ __forceinline__ int lds_byte(int r, int c) { const int st = (r >> 4) * 2 + (c >> 5), rr = r & 15, cc = c & 31, ob = rr * 64 + cc * 2; return st * 1024 + (ob ^ (((ob >> 9) & 1) << 5)); }
__host__ __device__ __forceinline__ void stage_rc(int b, int& R, int& C) { const int st = b / 1024, sb = b % 1024, swz = sb ^ (((sb >> 9) & 1) << 5); R = (st >> 1) * 16 + swz / 64; C = (st & 1) * 32 + (swz % 64) / 2; }
__host__ __device__ __forceinline__ int perm32(int rho) { const int n = rho >> 4, i = rho & 15; return 8 * (i >> 2) + 4 * n + (i & 3); }

struct Unit { int pm, pn; };
struct Gemm { const bf16_t* A; const bf16_t* Bt; int M, N, K; };

struct StaticOrder {
    int nM, nN, nwg, G, c;
    __host__ __device__ void init(int M, int N, int G_, int c_) { nM = M / BM; nN = N / BM; nwg = nM * nN; G = G_; c = c_; }
    __host__ __device__ bool next(int i, Unit& u) const {
        const long L = (long)i * G + c; if (L >= nwg) return false;
        int wgid = (int)L; { const int q = nwg / NXCD, r = nwg % NXCD, xcd = wgid % NXCD, off = wgid / NXCD; wgid = (xcd < r ? xcd * (q + 1) : r * (q + 1) + (xcd - r) * q) + off; }
        const int nig = WGM * nN, gid = wgid / nig, fm = gid * WGM, gsz = (nM - fm) < WGM ? (nM - fm) : WGM;
        u.pm = fm + ((wgid % nig) % gsz); u.pn = (wgid % nig) / gsz; return true;
    }
    __device__ __forceinline__ void a_ready(const Unit&) const {}
    __device__ __forceinline__ void done(const Unit&) const {}
};

typedef float f32x2 __attribute__((ext_vector_type(2))); typedef __bf16 bf16x2_t __attribute__((ext_vector_type(2)));
__device__ __forceinline__ unsigned cvt_pk_bf16(float lo, float hi) { const f32x2 v = {lo, hi}; const bf16x2_t b = __builtin_convertvector(v, bf16x2_t); return __builtin_bit_cast(unsigned, b); }
constexpr int TOK = 32768;
constexpr float QSCALE = 0.125f * 1.4426950408889634f;
__device__ __forceinline__ float sigm(float x) { return __builtin_amdgcn_rcpf(1.0f + __builtin_amdgcn_exp2f(-1.4426950408889634f * x)); }
__device__ __forceinline__ u32x4 pack8(const f32x4& a, const f32x4& b) { u32x4 w; w.x = cvt_pk_bf16(a[0], a[1]); w.y = cvt_pk_bf16(a[2], a[3]); w.z = cvt_pk_bf16(b[0], b[1]); w.w = cvt_pk_bf16(b[2], b[3]); return w; }
__device__ __forceinline__ void unpack8(const u32x4& w, f32x4& a, f32x4& b) {
    a[0] = __uint_as_float(w.x << 16); a[1] = __uint_as_float(w.x & 0xffff0000u); a[2] = __uint_as_float(w.y << 16); a[3] = __uint_as_float(w.y & 0xffff0000u);
    b[0] = __uint_as_float(w.z << 16); b[1] = __uint_as_float(w.z & 0xffff0000u); b[2] = __uint_as_float(w.w << 16); b[3] = __uint_as_float(w.w & 0xffff0000u); }

struct EpiInProj {
    static constexpr bool PERM = true, AFTER_DRAIN = false;
    bf16_t* H; const float* bg;
    __device__ __forceinline__ void operator()(const f32x4 (&acc)[2][2][4][2], const Unit& u, int wr, int wc, int fr, int fq) const {
        const int row0 = u.pm * BM + wr * 64 + fr;
        if (u.pn < 12) {
            const int seg = u.pn >> 1; const float sc = (seg == 0 || seg == 3) ? QSCALE : 1.0f;
            bf16_t* base = H + (size_t)seg * ((size_t)TOK * 512);
            const int col0 = (u.pn & 1) * 256 + wc * 32 + 8 * fq;
#pragma unroll
            for (int ai = 0; ai < 2; ++ai)
#pragma unroll
                for (int m = 0; m < 4; ++m) { bf16_t* rowp = base + (size_t)(row0 + ai * HALF + m * 16) * 512 + col0;
#pragma unroll
                    for (int bj = 0; bj < 2; ++bj) { const f32x4 v0 = acc[ai][bj][m][0] * sc, v1 = acc[ai][bj][m][1] * sc; *(u32x4*)(rowp + bj * HALF) = pack8(v0, v1); } }
        } else {
            const int t = u.pn - 12, g = t >> 2;
            bf16_t* base = H + (size_t)6 * TOK * 512 + (size_t)g * ((size_t)TOK * 1024);
            const int col0 = (t & 3) * 256 + wc * 32 + 8 * fq;
            f32x4 bv[2][2];
#pragma unroll
            for (int bj = 0; bj < 2; ++bj)
#pragma unroll
                for (int n = 0; n < 2; ++n) bv[bj][n] = *(const f32x4*)(bg + g * 1024 + col0 + bj * HALF + 4 * n);
#pragma unroll
            for (int ai = 0; ai < 2; ++ai)
#pragma unroll
                for (int m = 0; m < 4; ++m) { bf16_t* rowp = base + (size_t)(row0 + ai * HALF + m * 16) * 1024 + col0;
#pragma unroll
                    for (int bj = 0; bj < 2; ++bj) { f32x4 v0 = acc[ai][bj][m][0] + bv[bj][0], v1 = acc[ai][bj][m][1] + bv[bj][1];
#pragma unroll
                        for (int e = 0; e < 4; ++e) { v0[e] = sigm(v0[e]); v1[e] = sigm(v1[e]); }
                        *(u32x4*)(rowp + bj * HALF) = pack8(v0, v1); } }
        }
    }
};
struct EpiGate {
    static constexpr bool PERM = true, AFTER_DRAIN = false;
    bf16_t* mix; const bf16_t* gate; int add;
    __device__ __forceinline__ void operator()(const f32x4 (&acc)[2][2][4][2], const Unit& u, int wr, int wc, int fr, int fq) const {
        const int row0 = u.pm * BM + wr * 64 + fr, col0 = u.pn * BM + wc * 32 + 8 * fq;
#pragma unroll
        for (int ai = 0; ai < 2; ++ai)
#pragma unroll
            for (int m = 0; m < 4; ++m) { const size_t off = (size_t)(row0 + ai * HALF + m * 16) * 1024 + col0;
#pragma unroll
                for (int bj = 0; bj < 2; ++bj) { const u32x4 gw = *(const u32x4*)(gate + off + bj * HALF); f32x4 g0, g1; unpack8(gw, g0, g1);
                    f32x4 v0 = g0 * acc[ai][bj][m][0], v1 = g1 * acc[ai][bj][m][1];
                    if (add) { const u32x4 mw = *(const u32x4*)(mix + off + bj * HALF); f32x4 m0, m1; unpack8(mw, m0, m1); v0 += m0; v1 += m1; }
                    *(u32x4*)(mix + off + bj * HALF) = pack8(v0, v1); } }
    }
};
struct EpiRes {
    static constexpr bool PERM = false, AFTER_DRAIN = false;
    const float* res; float* out; float alpha;
    __device__ __forceinline__ void operator()(const f32x4 (&acc)[2][2][4][2], const Unit& u, int wr, int wc, int fr, int fq) const {
        const int row0 = u.pm * BM + wr * 64 + fr, col0 = u.pn * BM + wc * 32 + 4 * fq;
#pragma unroll
        for (int ai = 0; ai < 2; ++ai)
#pragma unroll
            for (int m = 0; m < 4; ++m) { const size_t off = (size_t)(row0 + ai * HALF + m * 16) * 1024 + col0;
#pragma unroll
                for (int bj = 0; bj < 2; ++bj)
#pragma unroll
                    for (int n = 0; n < 2; ++n) { const f32x4 r = *(const f32x4*)(res + off + bj * HALF + n * 16); *(f32x4*)(out + off + bj * HALF + n * 16) = r * alpha + acc[ai][bj][m][n]; } }
    }
};
struct EpiSwiGLU {
    static constexpr bool PERM = true, AFTER_DRAIN = false;
    bf16_t* hf;
    __device__ __forceinline__ void operator()(const f32x4 (&acc)[2][2][4][2], const Unit& u, int wr, int wc, int fr, int fq) const {
        const int row0 = u.pm * BM + wr * 64 + fr, col0 = u.pn * HALF + wc * 32 + 8 * fq;
#pragma unroll
        for (int ai = 0; ai < 2; ++ai)
#pragma unroll
            for (int m = 0; m < 4; ++m) { bf16_t* rowp = hf + (size_t)(row0 + ai * HALF + m * 16) * 2816 + col0;
                f32x4 h0, h1;
#pragma unroll
                for (int e = 0; e < 4; ++e) { const float g0 = acc[ai][0][m][0][e], g1 = acc[ai][0][m][1][e];
                    h0[e] = g0 * sigm(g0) * acc[ai][1][m][0][e]; h1[e] = g1 * sigm(g1) * acc[ai][1][m][1][e]; }
                *(u32x4*)rowp = pack8(h0, h1); }
    }
};

template <class Epi, class Sched, bool ALIGN_EPI = false, bool SP2 = false>
__device__ __forceinline__ void gemm_phase(PG8_LAS unsigned char* lds, const Gemm g, const Sched& S, const Epi& E) {
    int tid_ = threadIdx.x; asm volatile("" : "+v"(tid_));
    const int tid = tid_, wid = __builtin_amdgcn_readfirstlane(tid >> 6), lane = tid & 63, wr = wid >> 2, wc = wid & 3, fr = lane & 15, fq = lane >> 4;
    const int K = g.K, nt = K / BK;
    unsigned voffA[2], voffB[2];
#pragma unroll
    for (int i = 0; i < 2; ++i) { int R, C; stage_rc(tid * 16 + i * 8192, R, C); const int Rb = Epi::PERM ? ((R & ~31) + perm32(R & 31)) : R;
        voffA[i] = (unsigned)(R * K + C) * 2u; voffB[i] = (unsigned)(Rb * K + C) * 2u; }
    const size_t kstep = (size_t)(BK * 2);
    const size_t hstep = (size_t)HALF * K * 2;
    const size_t tstep = 2 * hstep;
    const unsigned ldsw = (unsigned)wid * 1024u;
    const int aoff = lds_byte(wr * 64 + fr, fq * 8), boff = lds_byte(wc * 32 + fr, fq * 8);
#define PG8_SA(b, h) (((b) * 2 + (h)) * HTB)
#define PG8_SB(b, h) ((4 + (b) * 2 + (h)) * HTB)
#define PG8_STAGE(bufoff, gbase, voff) do { _Pragma("unroll") for (int _i = 0; _i < 2; ++_i) \
        __builtin_amdgcn_global_load_lds((const unsigned*)((const char*)(gbase) + (voff)[_i]), (PG8_LAS unsigned*)(lds + (bufoff) + ldsw + _i * 8192), 16, 0, 0); } while (0)
#define PG8_LDA(dst, b, h) do { _Pragma("unroll") for (int m = 0; m < 4; ++m) _Pragma("unroll") for (int k = 0; k < 2; ++k) dst[m][k] = *(const PG8_LAS bf16x8*)(lds + PG8_SA(b, h) + aoff + m * 2048 + k * 1024); } while (0)
#define PG8_LDB(dst, b, h) do { _Pragma("unroll") for (int n = 0; n < 2; ++n) _Pragma("unroll") for (int k = 0; k < 2; ++k) dst[n][k] = *(const PG8_LAS bf16x8*)(lds + PG8_SB(b, h) + boff + n * 2048 + k * 1024); } while (0)
#define PG8_MMA(ai, bj, At, Bt) do { __builtin_amdgcn_s_setprio(1); _Pragma("unroll") for (int m = 0; m < 4; ++m) _Pragma("unroll") for (int n = 0; n < 2; ++n) _Pragma("unroll") for (int k = 0; k < 2; ++k) \
        acc[ai][bj][m][n] = __builtin_amdgcn_mfma_f32_16x16x32_bf16(Bt[n][k], At[m][k], acc[ai][bj][m][n], 0, 0, 0); __builtin_amdgcn_s_setprio(0); } while (0)
#define PG8_WAIT_V(n) asm volatile("s_waitcnt vmcnt(" #n ")" ::: "memory")
#define PG8_WAIT_L(n) asm volatile("s_waitcnt lgkmcnt(" #n ")" ::: "memory")
#define PG8_BAR __builtin_amdgcn_s_barrier()
#define PG8_SCHED __builtin_amdgcn_sched_barrier(0)
    Unit cur, nxt; int ui = 0;
    if (!S.next(0, cur)) return;
    f32x4 acc[2][2][4][2];
#pragma unroll
    for (int a = 0; a < 2; ++a)
#pragma unroll
        for (int b = 0; b < 2; ++b)
#pragma unroll
            for (int m = 0; m < 4; ++m)
#pragma unroll
                for (int n = 0; n < 2; ++n) acc[a][b][m][n] = (f32x4){0.f, 0.f, 0.f, 0.f};
    bf16x8 At[4][2], B0[2][2], B1[2][2];
    const char* cA = (const char*)g.A + (size_t)cur.pm * tstep; const char* cB = (const char*)g.Bt + (size_t)cur.pn * tstep;
    S.a_ready(cur);
    if constexpr (SP2) {
        PG8_STAGE(PG8_SB(0, 0), cB, voffB); PG8_STAGE(PG8_SB(0, 1), cB + hstep, voffB); PG8_STAGE(PG8_SA(0, 0), cA, voffA); PG8_STAGE(PG8_SA(0, 1), cA + hstep, voffA);
        if (wr == 1) PG8_BAR;
        PG8_WAIT_V(2); PG8_BAR;
        PG8_STAGE(PG8_SB(1, 0), cB + kstep, voffB); PG8_STAGE(PG8_SA(1, 0), cA + kstep, voffA); PG8_STAGE(PG8_SB(1, 1), cB + hstep + kstep, voffB);
        PG8_WAIT_V(6); PG8_BAR;
    } else {
        PG8_STAGE(PG8_SB(0, 0), cB, voffB); PG8_STAGE(PG8_SA(0, 0), cA, voffA); PG8_STAGE(PG8_SB(0, 1), cB + hstep, voffB); PG8_STAGE(PG8_SA(0, 1), cA + hstep, voffA);
        if (wr == 1) PG8_BAR;
        PG8_WAIT_V(4); PG8_BAR;
        PG8_STAGE(PG8_SB(1, 0), cB + kstep, voffB); PG8_STAGE(PG8_SA(1, 0), cA + kstep, voffA); PG8_STAGE(PG8_SB(1, 1), cB + hstep + kstep, voffB);
        PG8_WAIT_V(6); PG8_BAR;
    }
    for (;;) {
        const bool has_next = S.next(ui + 1, nxt);
        const char* nA = has_next ? (const char*)g.A + (size_t)nxt.pm * tstep : cA; const char* nB = has_next ? (const char*)g.Bt + (size_t)nxt.pn * tstep : cB;
        for (int t = 0; t < nt; t += 2) {
            const bool last = (t == nt - 2);
            const char* a1 = cA + (size_t)(t + 1) * kstep;
            const char* a2 = last ? nA : cA + (size_t)(t + 2) * kstep; const char* b2 = last ? nB : cB + (size_t)(t + 2) * kstep;
            const char* a3 = a2 + kstep; const char* b3 = b2 + kstep;
            if (last && has_next) S.a_ready(nxt);
            if constexpr (SP2) {
            PG8_LDB(B0, 0, 0); PG8_LDB(B1, 0, 1); PG8_SCHED; PG8_LDA(At, 0, 0); PG8_STAGE(PG8_SA(1, 1), a1 + hstep, voffA);
            PG8_WAIT_V(8); PG8_WAIT_L(0); PG8_BAR; PG8_MMA(0, 0, At, B0); PG8_MMA(0, 1, At, B1); PG8_BAR; PG8_SCHED;
            PG8_LDA(At, 0, 1); PG8_STAGE(PG8_SB(0, 0), b2, voffB); PG8_STAGE(PG8_SB(0, 1), b2 + hstep, voffB); PG8_STAGE(PG8_SA(0, 0), a2, voffA);
            PG8_WAIT_V(8); PG8_WAIT_L(0); PG8_BAR; PG8_MMA(1, 0, At, B0); PG8_MMA(1, 1, At, B1); PG8_BAR; PG8_SCHED;
            PG8_LDB(B0, 1, 0); PG8_LDB(B1, 1, 1); PG8_SCHED; PG8_LDA(At, 1, 0); PG8_STAGE(PG8_SA(0, 1), a2 + hstep, voffA);
            PG8_WAIT_V(8); PG8_WAIT_L(0); PG8_BAR; PG8_MMA(0, 0, At, B0); PG8_MMA(0, 1, At, B1); PG8_BAR; PG8_SCHED;
            PG8_LDA(At, 1, 1); PG8_STAGE(PG8_SB(1, 0), b3, voffB); PG8_STAGE(PG8_SB(1, 1), b3 + hstep, voffB); PG8_STAGE(PG8_SA(1, 0), a3, voffA);
            PG8_WAIT_V(8); PG8_WAIT_L(0); PG8_BAR; PG8_MMA(1, 0, At, B0); PG8_MMA(1, 1, At, B1); PG8_BAR; PG8_SCHED;
            } else {
            PG8_LDB(B0, 0, 0); PG8_SCHED; PG8_LDA(At, 0, 0); PG8_STAGE(PG8_SA(1, 1), a1 + hstep, voffA);
            PG8_WAIT_L(8); PG8_BAR; PG8_WAIT_L(0); PG8_MMA(0, 0, At, B0); PG8_BAR; PG8_SCHED;
            PG8_LDB(B1, 0, 1); PG8_STAGE(PG8_SB(0, 0), b2, voffB);
            PG8_BAR; PG8_WAIT_L(0); PG8_MMA(0, 1, At, B1); PG8_BAR;
            PG8_LDA(At, 0, 1); PG8_STAGE(PG8_SA(0, 0), a2, voffA);
            PG8_BAR; PG8_WAIT_L(0); PG8_MMA(1, 0, At, B0); PG8_BAR; PG8_SCHED;
            PG8_STAGE(PG8_SB(0, 1), b2 + hstep, voffB);
            PG8_WAIT_V(6); PG8_BAR; PG8_MMA(1, 1, At, B1); PG8_BAR;
            PG8_LDB(B0, 1, 0); PG8_SCHED; PG8_LDA(At, 1, 0); PG8_STAGE(PG8_SA(0, 1), a2 + hstep, voffA);
            PG8_WAIT_L(8); PG8_BAR; PG8_WAIT_L(0); PG8_MMA(0, 0, At, B0); PG8_BAR; PG8_SCHED;
            PG8_LDB(B1, 1, 1); PG8_STAGE(PG8_SB(1, 0), b3, voffB);
            PG8_BAR; PG8_WAIT_L(0); PG8_MMA(0, 1, At, B1); PG8_BAR;
            PG8_LDA(At, 1, 1); PG8_STAGE(PG8_SA(1, 0), a3, voffA);
            PG8_BAR; PG8_WAIT_L(0); PG8_MMA(1, 0, At, B0); PG8_BAR; PG8_SCHED;
            PG8_STAGE(PG8_SB(1, 1), b3 + hstep, voffB);
            PG8_WAIT_V(6); PG8_BAR; PG8_MMA(1, 1, At, B1); PG8_BAR;
            }
        }
        if constexpr (ALIGN_EPI) { if (wr == 0) PG8_BAR; }
        if constexpr (!Epi::AFTER_DRAIN) { E(acc, cur, wr, wc, fr, fq); S.done(cur); }
        if (!has_next) break;
#pragma unroll
        for (int a = 0; a < 2; ++a)
#pragma unroll
            for (int b = 0; b < 2; ++b)
#pragma unroll
                for (int m = 0; m < 4; ++m)
#pragma unroll
                    for (int n = 0; n < 2; ++n) acc[a][b][m][n] = (f32x4){0.f, 0.f, 0.f, 0.f};
        cur = nxt; cA = nA; cB = nB; ++ui;
        if constexpr (ALIGN_EPI) { if (wr == 1) PG8_BAR; }
    }
    PG8_WAIT_V(0);
    if constexpr (!ALIGN_EPI) { if (wr == 0) PG8_BAR; }
    PG8_BAR;
    if constexpr (Epi::AFTER_DRAIN) { E.fused(acc, cur, wr, wc, fr, fq, lds, wid, lane); S.done(cur); }
#undef PG8_SA
#undef PG8_SB
#undef PG8_STAGE
#undef PG8_LDA
#undef PG8_LDB
#undef PG8_MMA
#undef PG8_WAIT_V
#undef PG8_WAIT_L
#undef PG8_BAR
#undef PG8_SCHED
}
}
namespace att {
#define ALDS __attribute__((address_space(3)))
typedef unsigned short bf16;
typedef short bf16x8 __attribute__((ext_vector_type(8)));
typedef short s16x4 __attribute__((ext_vector_type(4)));
typedef short v4i16_t __attribute__((ext_vector_type(4)));
typedef float f32x16 __attribute__((ext_vector_type(16)));
typedef unsigned u32x4 __attribute__((ext_vector_type(4)));
typedef unsigned u32x2 __attribute__((ext_vector_type(2)));
constexpr int SEQ = 8192, PITCH = 512;
constexpr int KS_PITCH = 144, KS_SZ = 64 * KS_PITCH, VS_SZ = 8192;
template <int NH> struct Lay { static constexpr int VS_OFF = NH * KS_SZ, BIAS_OFF = VS_OFF + NH * VS_SZ, FLAG_OFF = BIAS_OFF + NH * 2064, END = FLAG_OFF + 64; };
constexpr int ATT_LDS = Lay<4>::END;
__device__ __forceinline__ int crow(int r, int hi) { return (r & 3) + 8 * (r >> 2) + 4 * hi; }
typedef float f32x2_t __attribute__((ext_vector_type(2))); typedef __bf16 bf16x2_t __attribute__((ext_vector_type(2)));
__device__ __forceinline__ unsigned cvtpk(float lo, float hi) { const f32x2_t v = {lo, hi}; const bf16x2_t b = __builtin_convertvector(v, bf16x2_t); return __builtin_bit_cast(unsigned, b); }
__device__ __forceinline__ s16x4 vtr(ALDS const unsigned char* p) { return __builtin_bit_cast(s16x4, __builtin_amdgcn_ds_read_tr16_b64_v4i16((ALDS v4i16_t*)p)); }
__device__ __forceinline__ float swap_sum(float x) { auto rr = __builtin_amdgcn_permlane32_swap(__float_as_uint(x), __float_as_uint(x), false, false); return __uint_as_float(rr[0]) + __uint_as_float(rr[1]); }
__device__ __forceinline__ float swap_max(float x) { auto rr = __builtin_amdgcn_permlane32_swap(__float_as_uint(x), __float_as_uint(x), false, false); return fmaxf(__uint_as_float(rr[0]), __uint_as_float(rr[1])); }

template <int NH> struct KVRegs { u32x4 k[NH], v[NH]; };
template <int NH> __device__ __forceinline__ void kv_load(KVRegs<NH>& R, const bf16* Kh, const bf16* Vh, long row0, int tid) {
    const size_t off = (size_t)(row0 + (tid >> 3)) * PITCH + (tid & 7) * 8;
#pragma unroll
    for (int hh = 0; hh < NH; ++hh) { R.k[hh] = *(const u32x4*)(Kh + off + hh * 64); R.v[hh] = *(const u32x4*)(Vh + off + hh * 64); }
}
template <int NH> __device__ __forceinline__ void kv_store(const KVRegs<NH>& R, ALDS unsigned char* lds, int tid) {
    const int row = tid >> 3, ch = tid & 7;
#pragma unroll
    for (int hh = 0; hh < NH; ++hh) {
        *(ALDS u32x4*)(lds + hh * KS_SZ + row * KS_PITCH + ch * 16) = R.k[hh];
        *(ALDS u32x4*)(lds + Lay<NH>::VS_OFF + hh * VS_SZ + (ch >> 2) * 4096 + row * 64 + (ch & 3) * 16) = R.v[hh];
    }
}
__device__ __forceinline__ void qk_tile(f32x16& p0, f32x16& p1, ALDS const unsigned char* ks_, const bf16x8 (&qf)[4], int r32, int hi) {
    ALDS const unsigned char* kb = ks_ + r32 * KS_PITCH + hi * 16;
    p0 = f32x16{}; p1 = f32x16{};
#pragma unroll
    for (int ks = 0; ks < 4; ++ks) {
        const bf16x8 a0 = *(ALDS const bf16x8*)(kb + ks * 32);
        const bf16x8 a1 = *(ALDS const bf16x8*)(kb + 32 * KS_PITCH + ks * 32);
        p0 = __builtin_amdgcn_mfma_f32_32x32x16_bf16(a0, qf[ks], p0, 0, 0, 0);
        p1 = __builtin_amdgcn_mfma_f32_32x32x16_bf16(a1, qf[ks], p1, 0, 0, 0);
    }
}
__device__ __forceinline__ void pv_tile(f32x16 (&o)[2], ALDS const unsigned char* vs, const f32x16& p0, const f32x16& p1, int lane, int hi) {
    ALDS const unsigned char* vp = vs + ((lane >> 4) & 1) * 32 + (lane & 3) * 8 + (4 * hi + ((lane & 15) >> 2)) * 64;
#pragma unroll
    for (int ks = 0; ks < 4; ++ks) {
        const f32x16& P = (ks < 2) ? p0 : p1; const int b = (ks & 1) * 8;
        u32x4 pw; pw.x = cvtpk(P[b], P[b + 1]); pw.y = cvtpk(P[b + 2], P[b + 3]); pw.z = cvtpk(P[b + 4], P[b + 5]); pw.w = cvtpk(P[b + 6], P[b + 7]);
        const bf16x8 pf = __builtin_bit_cast(bf16x8, pw);
#pragma unroll
        for (int d0 = 0; d0 < 2; ++d0) {
            const s16x4 lo = vtr(vp + d0 * 4096 + ks * 1024), h4 = vtr(vp + d0 * 4096 + ks * 1024 + 512);
            const bf16x8 vf = (bf16x8){lo[0], lo[1], lo[2], lo[3], h4[0], h4[1], h4[2], h4[3]};
            o[d0] = __builtin_amdgcn_mfma_f32_32x32x16_bf16(vf, pf, o[d0], 0, 0, 0);
        }
    }
}
__device__ __forceinline__ void load_q(bf16x8 (&qf)[4], const bf16* Qrow, int hi) {
#pragma unroll
    for (int ks = 0; ks < 4; ++ks) qf[ks] = *(const bf16x8*)(Qrow + ks * 16 + hi * 8);
}
__device__ __forceinline__ void store_o(bf16* Orow, const f32x16 (&o)[2], int hi, float s) {
#pragma unroll
    for (int d0 = 0; d0 < 2; ++d0)
#pragma unroll
        for (int g = 0; g < 4; ++g) { u32x2 w; w.x = cvtpk(o[d0][4 * g] * s, o[d0][4 * g + 1] * s); w.y = cvtpk(o[d0][4 * g + 2] * s, o[d0][4 * g + 3] * s);
            *(u32x2*)(Orow + 32 * d0 + 8 * g + 4 * hi) = w; }
}

template <int NH> __device__ __forceinline__ void band_unit(int b, int hg, int rb, const bf16* Q, const bf16* K, const bf16* V, bf16* O, const float* relb, ALDS unsigned char* lds) {
    constexpr int WPH = 8 / NH, NC = WPH / 2, ROWS = 32 * WPH;
    int tid_ = threadIdx.x; asm volatile("" : "+v"(tid_));
    const int tid = tid_, lane = tid & 63, r32 = lane & 31, hi = lane >> 5, wid = __builtin_amdgcn_readfirstlane(tid >> 6);
    const int hh = wid / WPH, ws = wid % WPH, h = NH * hg + hh;
    ALDS float* biasL = (ALDS float*)(lds + Lay<NH>::BIAS_OFF) + hh * 516;
    ALDS const unsigned char* ksb = lds + hh * KS_SZ; ALDS const unsigned char* vsb = lds + Lay<NH>::VS_OFF + hh * VS_SZ;
    __syncthreads();
    for (int i = tid; i < NH * 513; i += 512) { const int a = i / 513, k = i - a * 513; ((ALDS float*)(lds + Lay<NH>::BIAS_OFF))[a * 516 + k] = relb[(NH * hg + a) * 513 + k] * 1.4426950408889634f; }
    const long rowbase = (long)b * SEQ; const int qw = ROWS * rb + 32 * ws, c = NC * rb + (ws >> 1);
    const bf16* Kh = K + NH * hg * 64; const bf16* Vh = V + NH * hg * 64;
    bf16x8 qf[4]; load_q(qf, Q + (size_t)(rowbase + qw + r32) * PITCH + h * 64, hi);
    float mrun = -1e30f, lrun = 0.f; f32x16 o[2]; o[0] = f32x16{}; o[1] = f32x16{};
    const int jlo = (NC * rb - 8 > 0) ? NC * rb - 8 : 0, jhi = NC * rb + NC - 1;
    KVRegs<NH> R; kv_load<NH>(R, Kh, Vh, rowbase + 64 * jlo, tid);
    for (int jc = jlo; jc <= jhi; ++jc) {
        __syncthreads();
        kv_store<NH>(R, lds, tid);
        if (jc < jhi) kv_load<NH>(R, Kh, Vh, rowbase + 64 * (jc + 1), tid);
        __syncthreads();
        if (NC == 1 || (jc >= c - 8 && jc <= c)) {
            f32x16 p0, p1; qk_tile(p0, p1, ksb, qf, r32, hi);
            float mx = -1e30f;
            if (c - jc >= 5) {
                const float bc = biasL[512];
#pragma unroll
                for (int r = 0; r < 16; ++r) { p0[r] += bc; p1[r] += bc; mx = fmaxf(mx, fmaxf(p0[r], p1[r])); }
            } else {
                const int tb = qw + r32 - 64 * jc + 256;
#pragma unroll
                for (int r = 0; r < 16; ++r) { const int i0 = tb - crow(r, hi), i1 = i0 - 32;
                    p0[r] += biasL[i0 < 512 ? i0 : 512]; p1[r] += biasL[i1 < 512 ? i1 : 512]; mx = fmaxf(mx, fmaxf(p0[r], p1[r])); }
            }
            mx = swap_max(mx);
            const float mnew = fmaxf(mrun, mx), al = __builtin_amdgcn_exp2f(mrun - mnew); mrun = mnew;
            float rs = 0.f;
#pragma unroll
            for (int r = 0; r < 16; ++r) { p0[r] = __builtin_amdgcn_exp2f(p0[r] - mnew); p1[r] = __builtin_amdgcn_exp2f(p1[r] - mnew); rs += p0[r] + p1[r]; }
            lrun = lrun * al + rs;
#pragma unroll
            for (int r = 0; r < 16; ++r) { o[0][r] *= al; o[1][r] *= al; }
            pv_tile(o, vsb, p0, p1, lane, hi);
        }
    }
    const float inv = 1.0f / swap_sum(lrun);
    store_o(O + (size_t)(rowbase + qw + r32) * PITCH + h * 64, o, hi, inv);
}

template <int NH> __device__ __forceinline__ void stick_unit(int b, int hg, int rb, const bf16* Q, const bf16* K, const bf16* V, bf16* O, ALDS unsigned char* lds) {
    constexpr int WPH = 8 / NH, ROWS = 32 * WPH, TPB = ROWS / 64 > 0 ? ROWS / 64 : 1;
    int tid_ = threadIdx.x; asm volatile("" : "+v"(tid_));
    const int tid = tid_, lane = tid & 63, r32 = lane & 31, hi = lane >> 5, wid = __builtin_amdgcn_readfirstlane(tid >> 6);
    const int hh = wid / WPH, ws = wid % WPH, h = NH * hg + hh;
    ALDS volatile unsigned* flag = (ALDS volatile unsigned*)(lds + Lay<NH>::FLAG_OFF);
    ALDS const unsigned char* ksb = lds + hh * KS_SZ; ALDS const unsigned char* vsb = lds + Lay<NH>::VS_OFF + hh * VS_SZ;
    const long rowbase = (long)b * SEQ; const int qw = ROWS * rb + 32 * ws, t = qw + r32;
    const bf16* Kh = K + NH * hg * 64; const bf16* Vh = V + NH * hg * 64;
    bf16x8 qf[4]; load_q(qf, Q + (size_t)(rowbase + t) * PITCH + h * 64, hi);
    float carry = 0.f; f32x16 o[2]; o[0] = f32x16{}; o[1] = f32x16{};
    const float lomask = hi ? 0.f : 1.f;
    const int jt = (ROWS * rb + ROWS - 1) / 64;
    unsigned done = 0u;
    KVRegs<NH> R; kv_load<NH>(R, Kh, Vh, rowbase + 64 * jt, tid);
    __syncthreads();
    for (int j = jt; j >= 0; --j) {
        __syncthreads();
        if (j < jt) { unsigned all = 1u;
#pragma unroll
            for (int w = 0; w < 8; ++w) all &= flag[w];
            if (all) break; }
        kv_store<NH>(R, lds, tid);
        if (j > 0) kv_load<NH>(R, Kh, Vh, rowbase + 64 * (j - 1), tid);
        __syncthreads();
        const int k0 = 64 * j;
        if (!done && k0 <= qw + 30) {
            f32x16 p0, p1, L0, L1; qk_tile(p0, p1, ksb, qf, r32, hi);
#pragma unroll
            for (int r = 0; r < 16; ++r) {
                { const float y = p0[r], lg = __builtin_amdgcn_logf(1.0f + __builtin_amdgcn_exp2f(-fabsf(y))); p0[r] = fminf(y, 0.f) - lg; L0[r] = fminf(-y, 0.f) - lg; }
                { const float y = p1[r], lg = __builtin_amdgcn_logf(1.0f + __builtin_amdgcn_exp2f(-fabsf(y))); p1[r] = fminf(y, 0.f) - lg; L1[r] = fminf(-y, 0.f) - lg; }
            }
            if (k0 + 63 >= qw) {
#pragma unroll
                for (int r = 0; r < 16; ++r) { const int kv = k0 + crow(r, hi);
                    if (kv >= t) { p0[r] = -1e30f; L0[r] = 0.f; }
                    if (kv + 32 >= t) { p1[r] = -1e30f; L1[r] = 0.f; } }
            }
            float T[8], H[8];
#pragma unroll
            for (int i = 0; i < 4; ++i) { const float g0 = (L0[4 * i] + L0[4 * i + 1]) + (L0[4 * i + 2] + L0[4 * i + 3]), g1 = (L1[4 * i] + L1[4 * i + 1]) + (L1[4 * i + 2] + L1[4 * i + 3]);
                T[i] = swap_sum(g0); H[i] = T[i] - g0; T[4 + i] = swap_sum(g1); H[4 + i] = T[4 + i] - g1; }
            float A = 0.f;
#pragma unroll
            for (int i = 7; i >= 4; --i) { const int bq = 4 * (i - 4); const float s3 = carry + A + lomask * H[i], s2 = s3 + L1[bq + 3], s1 = s2 + L1[bq + 2], s0 = s1 + L1[bq + 1];
                p1[bq + 3] = __builtin_amdgcn_exp2f(p1[bq + 3] + s3); p1[bq + 2] = __builtin_amdgcn_exp2f(p1[bq + 2] + s2); p1[bq + 1] = __builtin_amdgcn_exp2f(p1[bq + 1] + s1); p1[bq] = __builtin_amdgcn_exp2f(p1[bq] + s0);
                A += T[i]; }
#pragma unroll
            for (int i = 3; i >= 0; --i) { const int bq = 4 * i; const float s3 = carry + A + lomask * H[i], s2 = s3 + L0[bq + 3], s1 = s2 + L0[bq + 2], s0 = s1 + L0[bq + 1];
                p0[bq + 3] = __builtin_amdgcn_exp2f(p0[bq + 3] + s3); p0[bq + 2] = __builtin_amdgcn_exp2f(p0[bq + 2] + s2); p0[bq + 1] = __builtin_amdgcn_exp2f(p0[bq + 1] + s1); p0[bq] = __builtin_amdgcn_exp2f(p0[bq] + s0);
                A += T[i]; }
            carry += A;
            pv_tile(o, vsb, p0, p1, lane, hi);
            done = __all(carry < -160.0f) ? 1u : 0u;
        }
        if (lane == 0) flag[wid] = done;
    }
    store_o(O + (size_t)(rowbase + t) * PITCH + h * 64, o, hi, 1.0f);
}
#undef ALDS
}

#include <hip/hip_cooperative_groups.h>
namespace cg = cooperative_groups;
#define LAS __attribute__((address_space(3)))
typedef unsigned short bf16;
typedef unsigned v4u __attribute__((ext_vector_type(4)));
typedef unsigned v2u __attribute__((ext_vector_type(2)));
typedef float f32x4 __attribute__((ext_vector_type(4)));

#ifndef MK_PROBE
#define MK_PROBE 0
#endif
#ifndef ATT_NH_A
#define ATT_NH_A 4
#endif
#ifndef ATT_NH_B
#define ATT_NH_B 4
#endif
constexpr int NWAVES = 8, NTHR = 512;
constexpr int BATCH = 4, SEQ = 8192, M = BATCH * SEQ, D = 1024, DEPTH = 2, WA = 512, NIN = 5120, DFF = 2816, NFF = 2 * DFF, NREL = 513;
constexpr float DN_ALPHA = 1.4142135623730951f;
constexpr float LN_EPS = 1e-5f;
static_assert(M == pg8::TOK, "token rows");
constexpr size_t MiB = 1u << 20;
constexpr size_t WS_CTL = 0, CTL_ZERO_BYTES = 16384;
constexpr size_t WS_W = 1 * MiB, W_LAYER = 31 * MiB;
constexpr size_t OW_IN = 0, OW_PA = 10 * MiB, OW_PB = 11 * MiB, OW_OUT = 12 * MiB, OW_FI = 14 * MiB, OW_FO = 25 * MiB;
constexpr size_t WS_XB = 64 * MiB;
constexpr size_t WS_H = 128 * MiB;
constexpr size_t WS_R = 128 * MiB;
constexpr size_t WS_HF = 256 * MiB;
constexpr size_t WS_END = 448 * MiB;
static_assert(WS_W + 2 * W_LAYER <= WS_XB && WS_HF + (size_t)M * DFF * 2 <= WS_END && OW_FO + (size_t)D * DFF * 2 <= W_LAYER, "d_ws map");
constexpr int RING_BYTES = 131072, MISC_OFF = RING_BYTES, LDS_BYTES = 147456;
static_assert(att::ATT_LDS <= RING_BYTES, "attention scratch inside the ring");

__device__ __forceinline__ unsigned f2bf(float f) { unsigned u = __builtin_bit_cast(unsigned, f); return (u + 0x7fffu + ((u >> 16) & 1u)) >> 16; }
__device__ __forceinline__ unsigned pk2(float lo, float hi) { return f2bf(lo) | (f2bf(hi) << 16); }
__device__ __forceinline__ float wave_sum(float v) {
#pragma unroll
    for (int o = 1; o < 64; o <<= 1) v += __shfl_xor(v, o);
    return v;
}
template <bool FFI>
__device__ __forceinline__ void transpose_item(const float* W, int K, int N, bf16* WT, LAS float* scr, int item, int lane) {
    const int nblk = N / 32, kb = item / nblk, nb = item % nblk, k0 = 64 * kb, n0 = 32 * nb;
#pragma unroll 8
    for (int i = 0; i < 32; ++i) { const int kk = 2 * i + (lane >> 5); scr[kk * 33 + (lane & 31)] = W[(size_t)(k0 + kk) * N + n0 + (lane & 31)]; }
    asm volatile("s_waitcnt lgkmcnt(0)" ::: "memory");
    int r0 = n0;
    if (FFI) { const int half = n0 >= DFF, nn = half ? n0 - DFF : n0; r0 = 256 * (nn / 128) + 128 * half + (nn % 128); }
    const int c = lane & 7;
#pragma unroll
    for (int j = 0; j < 4; ++j) { const int n = (lane >> 3) + 8 * j; const LAS float* s = scr + (8 * c) * 33 + n;
        v4u o; o.x = pk2(s[0 * 33], s[1 * 33]); o.y = pk2(s[2 * 33], s[3 * 33]); o.z = pk2(s[4 * 33], s[5 * 33]); o.w = pk2(s[6 * 33], s[7 * 33]);
        *(v4u*)(WT + (size_t)(r0 + n) * K + k0 + 8 * c) = o; }
    asm volatile("s_waitcnt lgkmcnt(0)" ::: "memory");
}
#define RLX_AGENT __ATOMIC_RELAXED, __HIP_MEMORY_SCOPE_AGENT
#define XB_TMO      128
#define XB_XCNT(j)  (256  + 64 * (j))
#define XB_XSUB(j)  (1280 + 64 * (j))
#define XB_XGEN(j)  (2304 + 64 * (j))
#define XB_TOP      3328
#define XB_TOPGEN   3392
#define XCD_BAR_WORDS 3456
#define XB_SPIN_CAP (1u << 18)

__device__ __forceinline__ unsigned xb_ld(unsigned* p)              { return __hip_atomic_load(p, __ATOMIC_RELAXED, __HIP_MEMORY_SCOPE_AGENT); }
__device__ __forceinline__ unsigned xb_add(unsigned* p, unsigned v) { return __hip_atomic_fetch_add(p, v, __ATOMIC_RELAXED, __HIP_MEMORY_SCOPE_AGENT); }
__device__ __forceinline__ unsigned xb_xcc_id() { return (unsigned)__builtin_amdgcn_s_getreg((3 << 11) | 20) & 0xFu; }
#define XB_SPIN(cond, bar) do { unsigned _sp = 0; while (cond) { __builtin_amdgcn_s_sleep(1); \
    if ((++_sp & 255u) == 0u) { if (xb_ld(&(bar)[XB_TMO])) break; if (_sp > XB_SPIN_CAP) { atomicAdd(&(bar)[XB_TMO], 1u); break; } } } } while (0)

struct XcdBarrier {
    unsigned* bar; unsigned x;
    volatile LAS unsigned* st;
};

__device__ __forceinline__ XcdBarrier xcd_barrier_post(unsigned* bar, volatile LAS unsigned* st) {
    XcdBarrier b; b.bar = bar; b.x = xb_xcc_id(); b.st = st;
    if (threadIdx.x == 0) (void)xb_add(&bar[XB_XCNT(b.x)], 1u);
    return b;
}
__device__ __forceinline__ void xcd_barrier_complete(unsigned* bar, unsigned x, unsigned& nloc, unsigned& nx) {
    const unsigned G = gridDim.x * gridDim.y * gridDim.z;
    unsigned sum, cnt, mine, sp = 0u;
    for (;;) {
        sum = 0u; cnt = 0u; mine = 0u;
#pragma unroll
        for (unsigned j = 0; j < 16; ++j) { const unsigned c = xb_ld(&bar[XB_XCNT(j)]); sum += c; cnt += (c > 0u) ? 1u : 0u; mine = (j == x) ? c : mine; }
        if (sum == G) break;
        __builtin_amdgcn_s_sleep(1);
        if ((++sp & 255u) == 0u) { if (xb_ld(&bar[XB_TMO])) break; if (sp > XB_SPIN_CAP) { atomicAdd(&bar[XB_TMO], 1u); break; } }
    }
    nloc = mine > 0u ? mine : 1u; nx = cnt > 0u ? cnt : 1u;
}

__device__ __forceinline__ void xcd_barrier(const XcdBarrier& b) {
    asm volatile("s_waitcnt vmcnt(0)" ::: "memory");
    __syncthreads();
    if (threadIdx.x == 0) {
        unsigned* bar = b.bar;
        __builtin_amdgcn_s_waitcnt(0);
        unsigned nloc = b.st[0], nx = b.st[1];
        if (nloc == 0u) { xcd_barrier_complete(bar, b.x, nloc, nx); b.st[0] = nloc; b.st[1] = nx; }
        const unsigned old = xb_add(&bar[XB_XSUB(b.x)], 1u);
        const unsigned gen = old / nloc;
        if (old + 1u == (gen + 1u) * nloc) {
            __builtin_amdgcn_fence(__ATOMIC_RELEASE, "agent");
            asm volatile("s_waitcnt vmcnt(0)" ::: "memory");
            const unsigned og = xb_add(&bar[XB_TOP], 1u);
            const unsigned tg = og / nx;
            if (og + 1u == (tg + 1u) * nx) xb_add(&bar[XB_TOPGEN], 1u);
            else XB_SPIN(xb_ld(&bar[XB_TOPGEN]) == tg, bar);
            __builtin_amdgcn_fence(__ATOMIC_ACQUIRE, "agent");
            xb_add(&bar[XB_XGEN(b.x)], 1u);
            asm volatile("s_waitcnt vmcnt(0)" ::: "memory");
        } else {
            XB_SPIN(xb_ld(&bar[XB_XGEN(b.x)]) == gen, bar);
            __builtin_amdgcn_fence(__ATOMIC_ACQUIRE, "agent");
            asm volatile("s_waitcnt vmcnt(0)" ::: "memory");
        }
    }
    __syncthreads();
}

struct Args { const float* in[13]; float* out; unsigned char* ws; int ph_lo, ph_hi; };
constexpr int N_PHASES = 1 + 8 * DEPTH;

__global__ void __launch_bounds__(NTHR, 2) mk_fwd(Args args) {
    extern __shared__ __attribute__((aligned(16))) unsigned char lds_raw[];
    LAS unsigned char* lds = (LAS unsigned char*)lds_raw;
    const int G = gridDim.x, bx = blockIdx.x;
    unsigned char* ws = args.ws;
    const float* x_in = args.in[0];
    bf16* XB = (bf16*)(ws + WS_XB); bf16* Oa = XB; bf16* Ob = XB + (size_t)M * WA;
    bf16* Hb = (bf16*)(ws + WS_H);
    bf16 *Qa = Hb, *Ka = Hb + (size_t)1 * M * WA, *Va = Hb + (size_t)2 * M * WA, *Qb = Hb + (size_t)3 * M * WA, *Kb = Hb + (size_t)4 * M * WA, *Vb = Hb + (size_t)5 * M * WA;
    bf16 *Ga = Hb + (size_t)6 * M * WA, *Gb = Ga + (size_t)M * D;
    float* Rb = (float*)(ws + WS_R); bf16* HF = (bf16*)(ws + WS_HF);
    float* XF = args.out;
    cg::grid_group grid = cg::this_grid();
    volatile LAS unsigned* MISC = (volatile LAS unsigned*)(lds + MISC_OFF);
    if (threadIdx.x < 32) MISC[threadIdx.x] = 0u;
    __syncthreads();
    XcdBarrier bar = xcd_barrier_post((unsigned*)(ws + WS_CTL), MISC + 8);

    for (int ph = args.ph_lo; ph < args.ph_hi; ++ph) {
        int tid_ = threadIdx.x; asm volatile("" : "+v"(tid_));
        const int tid = tid_, lane = tid & 63, wave = __builtin_amdgcn_readfirstlane(tid >> 6);
        const int gw = bx * NWAVES + wave, NGW = G * NWAVES;
        if (ph == 0) {
            LAS float* scr = (LAS float*)(lds + wave * 16384);
            for (int l = 0; l < DEPTH; ++l) {
                unsigned char* wl = ws + WS_W + (size_t)l * W_LAYER;
                constexpr int I_IN = (D / 64) * (NIN / 32), I_P = (WA / 64) * (D / 32), I_O = (D / 64) * (D / 32), I_FI = (D / 64) * (NFF / 32), I_FO = (DFF / 64) * (D / 32);
                constexpr int NIT = I_IN + 2 * I_P + I_O + I_FI + I_FO;
                for (int it = gw; it < NIT; it += NGW) {
                    int r = it;
                    if (r < I_IN) { transpose_item<false>(args.in[1] + (size_t)l * D * NIN, D, NIN, (bf16*)(wl + OW_IN), scr, r, lane); continue; } r -= I_IN;
                    if (r < I_P) { transpose_item<false>(args.in[4] + (size_t)l * WA * D, WA, D, (bf16*)(wl + OW_PA), scr, r, lane); continue; } r -= I_P;
                    if (r < I_P) { transpose_item<false>(args.in[5] + (size_t)l * WA * D, WA, D, (bf16*)(wl + OW_PB), scr, r, lane); continue; } r -= I_P;
                    if (r < I_O) { transpose_item<false>(args.in[6] + (size_t)l * D * D, D, D, (bf16*)(wl + OW_OUT), scr, r, lane); continue; } r -= I_O;
                    if (r < I_FI) { transpose_item<true>(args.in[9] + (size_t)l * D * NFF, D, NFF, (bf16*)(wl + OW_FI), scr, r, lane); continue; } r -= I_FI;
                    transpose_item<false>(args.in[10] + (size_t)l * DFF * D, DFF, D, (bf16*)(wl + OW_FO), scr, r, lane);
                }
            }
            for (size_t i = (size_t)bx * NTHR + tid; i < (size_t)M * D / 8; i += (size_t)G * NTHR) {
                const f32x4 a = *(const f32x4*)(x_in + 8 * i), b = *(const f32x4*)(x_in + 8 * i + 4);
                v4u o; o.x = pk2(a[0], a[1]); o.y = pk2(a[2], a[3]); o.z = pk2(b[0], b[1]); o.w = pk2(b[2], b[3]);
                *(v4u*)(XB + 8 * i) = o;
            }
        } else {
            const int l = (ph - 1) >> 3, sp = (ph - 1) & 7;
            unsigned char* wl = ws + WS_W + (size_t)l * W_LAYER;
            if (sp == 0) {
                pg8::Gemm g{XB, (const bf16*)(wl + OW_IN), M, NIN, D}; pg8::StaticOrder S; S.init(M, NIN, G, bx);
                pg8::EpiInProj E{Hb, args.in[2] + (size_t)l * 2 * D};
                pg8::gemm_phase<pg8::EpiInProj, pg8::StaticOrder, true, true>(lds, g, S, E);
            } else if (sp == 1) {
                const float* relb = args.in[3] + (size_t)l * 8 * NREL;
                constexpr int NHA = ATT_NH_A, NHB = ATT_NH_B, NBA = 32 * NHA, NBB = 32 * NHB, UA = BATCH * (8 / NHA) * NBA, UB = BATCH * (8 / NHB) * NBB;
                for (int u = bx; u < UA + UB; u += G) {
                    if (u < UA) { const int rb = NBA - 1 - u % NBA, hg = (u / NBA) % (8 / NHA), b = u / (NBA * (8 / NHA));
                        att::band_unit<NHA>(b, hg, rb, Qa, Ka, Va, Oa, relb, lds); if (MK_PROBE & 1) att::band_unit<NHA>(b, hg, rb, Qa, Ka, Va, Oa, relb, lds); }
                    else { const int v = u - UA, rb = NBB - 1 - v % NBB, hg = (v / NBB) % (8 / NHB), b = v / (NBB * (8 / NHB));
                        att::stick_unit<NHB>(b, hg, rb, Qb, Kb, Vb, Ob, lds); if (MK_PROBE & 2) att::stick_unit<NHB>(b, hg, rb, Qb, Kb, Vb, Ob, lds); }
                }
                __syncthreads();
            } else if (sp == 2) {
                { pg8::Gemm g{Oa, (const bf16*)(wl + OW_PA), M, D, WA}; pg8::StaticOrder S; S.init(M, D, G, bx);
                  pg8::EpiGate E{Ga, Ga, 0};
                  pg8::gemm_phase<pg8::EpiGate, pg8::StaticOrder, true, true>(lds, g, S, E); }
                { pg8::Gemm g{Ob, (const bf16*)(wl + OW_PB), M, D, WA}; pg8::StaticOrder S; S.init(M, D, G, bx);
                  pg8::EpiGate E{Ga, Gb, 1};
                  pg8::gemm_phase<pg8::EpiGate, pg8::StaticOrder, true, true>(lds, g, S, E); }
            } else if (sp == 3) {
                pg8::Gemm g{Ga, (const bf16*)(wl + OW_OUT), M, D, D}; pg8::StaticOrder S; S.init(M, D, G, bx);
                pg8::EpiRes E{l == 0 ? x_in : (const float*)XF, Rb, DN_ALPHA};
                pg8::gemm_phase<pg8::EpiRes, pg8::StaticOrder, true, true>(lds, g, S, E);
            } else if (sp == 4 || sp == 7) {
                const float* gam = args.in[sp == 4 ? 7 : 11] + (size_t)l * D; const float* bet = args.in[sp == 4 ? 8 : 12] + (size_t)l * D;
                f32x4 gv[4], bv[4];
#pragma unroll
                for (int j = 0; j < 4; ++j) { gv[j] = *(const f32x4*)(gam + 4 * lane + 256 * j); bv[j] = *(const f32x4*)(bet + 4 * lane + 256 * j); }
                for (int m = gw; m < M; m += NGW) {
                    const float* rr = Rb + (size_t)m * D + 4 * lane;
                    f32x4 v[4]; float s = 0.f;
#pragma unroll
                    for (int j = 0; j < 4; ++j) { v[j] = *(const f32x4*)(rr + 256 * j); s += (v[j][0] + v[j][1]) + (v[j][2] + v[j][3]); }
                    const float mean = wave_sum(s) * (1.f / D); float s2 = 0.f;
#pragma unroll
                    for (int j = 0; j < 4; ++j) { v[j] = v[j] - mean; s2 += (v[j][0] * v[j][0] + v[j][1] * v[j][1]) + (v[j][2] * v[j][2] + v[j][3] * v[j][3]); }
                    const float rstd = 1.f / sqrtf(wave_sum(s2) * (1.f / D) + LN_EPS);
#pragma unroll
                    for (int j = 0; j < 4; ++j) { const f32x4 y = v[j] * rstd * gv[j] + bv[j];
                        *(f32x4*)(XF + (size_t)m * D + 4 * lane + 256 * j) = y;
                        v2u o; o.x = pk2(y[0], y[1]); o.y = pk2(y[2], y[3]); *(v2u*)(XB + (size_t)m * D + 4 * lane + 256 * j) = o; }
                }
            } else if (sp == 5) {
                pg8::Gemm g{XB, (const bf16*)(wl + OW_FI), M, NFF, D}; pg8::StaticOrder S; S.init(M, NFF, G, bx);
                pg8::EpiSwiGLU E{HF};
                pg8::gemm_phase<pg8::EpiSwiGLU, pg8::StaticOrder, true, true>(lds, g, S, E);
            } else {
                pg8::Gemm g{HF, (const bf16*)(wl + OW_FO), M, D, DFF}; pg8::StaticOrder S; S.init(M, D, G, bx);
                pg8::EpiRes E{(const float*)XF, Rb, DN_ALPHA};
                pg8::gemm_phase<pg8::EpiRes, pg8::StaticOrder, true, true>(lds, g, S, E);
            }
        }
        if (ph + 1 < args.ph_hi) { if (args.ph_hi > 1000) grid.sync(); else xcd_barrier(bar); }
    }
}

#ifndef MK_PROBE
#define MK_PROBE 0
#endif
#ifndef MK_MULTI
#define MK_MULTI 0
#endif
extern "C" void kernel_launch(void* const* d_in, const int* in_sizes, int n_in, void* d_out, int out_size, void* d_ws, size_t ws_size, hipStream_t stream) {
    static int grid = 0;
    if (grid == 0) {
        if (n_in != 13 || in_sizes[0] != M * D || out_size != M * D || ws_size < WS_END) { fprintf(stderr, "kernel_launch: unexpected shapes (n_in %d, in0 %d, out %d, ws %zu); nothing launched\n", n_in, n_in > 0 ? in_sizes[0] : -1, out_size, ws_size); grid = -1; return; }
        int dev = 0, cus = 0, per_cu = 0;
        if (hipGetDevice(&dev) != hipSuccess || hipDeviceGetAttribute(&cus, hipDeviceAttributeMultiprocessorCount, dev) != hipSuccess) { grid = -1; return; }
        if (hipFuncSetAttribute((const void*)mk_fwd, hipFuncAttributeMaxDynamicSharedMemorySize, LDS_BYTES) != hipSuccess) { fprintf(stderr, "kernel_launch: hipFuncSetAttribute failed\n"); grid = -1; return; }
        if (hipOccupancyMaxActiveBlocksPerMultiprocessor(&per_cu, (const void*)mk_fwd, NTHR, LDS_BYTES) != hipSuccess || per_cu < 1) { fprintf(stderr, "kernel_launch: occupancy query says %d\n", per_cu); per_cu = 1; }
        (void)hipGetLastError();
        grid = cus * 1;
    }
    if (grid < 0) return;
    if (hipMemsetAsync((char*)d_ws + WS_CTL, 0, CTL_ZERO_BYTES, stream) != hipSuccess) { fprintf(stderr, "kernel_launch: hipMemsetAsync failed\n"); return; }
    Args a{};
    for (int i = 0; i < 13; ++i) a.in[i] = (const float*)d_in[i];
    a.out = (float*)d_out; a.ws = (unsigned char*)d_ws;
#if MK_MULTI
    for (int ph = 0; ph < N_PHASES; ++ph) { a.ph_lo = ph; a.ph_hi = ph + 1; hipLaunchKernelGGL(mk_fwd, dim3(grid), dim3(NTHR), LDS_BYTES, stream, a); }
#else
    a.ph_lo = 0; a.ph_hi = N_PHASES;
    void* kargs[] = {&a};
    hipError_t e = hipLaunchCooperativeKernel((const void*)mk_fwd, dim3(grid), dim3(NTHR), kargs, LDS_BYTES, stream);
    if (e != hipSuccess) fprintf(stderr, "kernel_launch: cooperative launch failed: %s (grid %d)\n", hipGetErrorString(e), grid);
#endif
}
```
